# Optimizing an MI355X kernel written in HIP

```python
import numpy as np
import jax
import jax.numpy as jnp
from jax import lax

D_MODEL = 1024
BATCH = 8
SEQ = 8192
DEPTH = 1

GRID_W = 64
NA_HEAD_DIM = 64
NA_HEADS = D_MODEL // 128
NA_WIDTH = NA_HEADS * NA_HEAD_DIM
NA_KH_MAX = 8
NA_KW = 16
HG_DK = 128
HG_DV = 128
HG_HEADS = D_MODEL // 256
HG_WIDTH = HG_HEADS * HG_DK
HG_VWIDTH = HG_HEADS * HG_DV
HG_CHUNK = 64
N_GROUPS = 4
EXPERTS_PER_GROUP = 8
N_EXPERTS = N_GROUPS * EXPERTS_PER_GROUP
TOP_K = 2
D_FF_EXPERT = D_MODEL // 2
MOE_BLOCK = 256
DN_ALPHA = (2 * DEPTH) ** 0.25
DN_BETA = (8 * DEPTH) ** -0.25
LN_EPS = 1e-5
RMS_EPS = 1e-6
IN_SIZES = (NA_WIDTH, NA_WIDTH, NA_WIDTH, HG_WIDTH, HG_WIDTH, HG_WIDTH, HG_VWIDTH, HG_VWIDTH, D_MODEL, D_MODEL)
D_IN = sum(IN_SIZES)

kernel_name = 'hybrid_na_hgrn2_hmoe_encoder'


def layer_norm(x, g, b):
    xf = x.astype(jnp.float32)
    mu = jnp.mean(xf, axis=-1, keepdims=True)
    xc = xf - mu
    var = jnp.mean(xc * xc, axis=-1, keepdims=True)
    return (xc * lax.rsqrt(var + LN_EPS) * g.astype(jnp.float32) + b.astype(jnp.float32)).astype(x.dtype)


def neighbourhood_attention(q, k, v, rpb):
    b, s, h, dh = q.shape
    rows = s // GRID_W
    kh = min(NA_KH_MAX, rows)

    def to_grid(t):
        return t.reshape(b, rows, GRID_W, h, dh).transpose(0, 3, 1, 2, 4)

    qg = to_grid(q * (dh ** -0.5))
    kg = to_grid(k)
    vg = to_grid(v)
    cols = np.arange(GRID_W)
    col_start = np.clip(cols - NA_KW // 2, 0, GRID_W - NA_KW)
    col_idx = col_start[:, None] + np.arange(NA_KW)[None, :]
    col_off = col_idx - cols[:, None] + (NA_KW - 1)

    def row_block(r):
        rs = jnp.clip(r - kh // 2, 0, rows - kh)
        q_row = lax.dynamic_index_in_dim(qg, r, axis=2, keepdims=False)
        k_band = lax.dynamic_slice_in_dim(kg, rs, kh, axis=2)
        v_band = lax.dynamic_slice_in_dim(vg, rs, kh, axis=2)
        k_win = k_band[:, :, :, col_idx]
        v_win = v_band[:, :, :, col_idx]
        row_off = rs + jnp.arange(kh) - r + (NA_KH_MAX - 1)
        bias = rpb[:, row_off][:, :, col_off].transpose(0, 2, 1, 3)
        scores = jnp.einsum('bhcd,bhrckd->bhcr k'.replace(' ', ''), q_row, k_win).astype(jnp.float32)
        scores = scores + bias[None].astype(jnp.float32)
        p = jax.nn.softmax(scores.reshape(b, h, GRID_W, kh * NA_KW), axis=-1)
        p = p.reshape(b, h, GRID_W, kh, NA_KW).astype(v.dtype)
        return jnp.einsum('bhcrk,bhrckd->bhcd', p, v_win)

    out = lax.map(row_block, jnp.arange(rows))
    return out.transpose(1, 0, 3, 2, 4).reshape(b, s, h * dh)


def gla_chunk_scan(q, k, v, log_f):
    _, b, n, c, dk = q.shape
    dv = v.shape[-1]
    causal = jnp.tril(jnp.ones((c, c), dtype=bool))

    def step(state, inp):
        qc, kc, vc, gc = inp
        bcum = jnp.cumsum(gc, axis=2)
        b_last = bcum[:, :, -1:, :]
        o_inter = jnp.einsum('bntk,bnkv->bntv', qc * jnp.exp(bcum), state)
        diff = bcum[:, :, :, None, :] - bcum[:, :, None, :, :]
        decay = jnp.exp(jnp.where(causal[:, :, None], diff, -jnp.inf))
        attn = jnp.einsum('bntk,bnsk,bntsk->bnts', qc, kc, decay)
        o_intra = jnp.einsum('bnts,bnsv->bntv', attn, vc)
        new_state = jnp.exp(b_last[:, :, 0, :])[..., None] * state + jnp.einsum(
            'bnsk,bnsv->bnkv', kc * jnp.exp(b_last - bcum), vc)
        return new_state, o_inter + o_intra

    init = jnp.zeros((b, n, dk, dv), jnp.float32)
    _, o = lax.scan(step, init, (q, k, v, log_f))
    return o


def hgrn2_bidirectional(q, f_fwd, f_bwd, i, g, lb, norm_g):
    b, s, h, dk = q.shape
    dv = i.shape[-1]
    f32 = jnp.float32
    qf = jax.nn.silu(q.astype(f32))
    lbr = lb.astype(f32).reshape(2, 1, 1, h, dk)
    forget = lbr + (1.0 - lbr) * jax.nn.sigmoid(jnp.stack([f_fwd, f_bwd]).astype(f32))
    log_f = jnp.log(forget)
    kk = 1.0 - forget
    vf = i.astype(f32)

    def rev(t):
        return jnp.flip(t, axis=1)

    qd = jnp.stack([qf, rev(qf)])
    kd = jnp.stack([kk[0], rev(kk[1])])
    vd = jnp.stack([vf, rev(vf)])
    gd = jnp.stack([log_f[0], rev(log_f[1])])
    nc = s // HG_CHUNK

    def to_chunks(t):
        d = t.shape[-1]
        return t.reshape(2, b, nc, HG_CHUNK, h, d).transpose(2, 1, 0, 4, 3, 5).reshape(nc, b, 2 * h, HG_CHUNK, d)

    o = gla_chunk_scan(to_chunks(qd), to_chunks(kd), to_chunks(vd), to_chunks(gd))
    o = o.reshape(nc, b, 2, h, HG_CHUNK, dv).transpose(2, 1, 0, 4, 3, 5).reshape(2, b, s, h, dv)
    o = o[0] + rev(o[1])
    o = o * lax.rsqrt(jnp.mean(o * o, axis=-1, keepdims=True) + RMS_EPS)
    o = o * norm_g.astype(f32).reshape(h, dv) * jax.nn.silu(g.astype(f32))
    return o.reshape(b, s, h * dv).astype(i.dtype)


def hierarchical_moe(x2d, w_rg, b_rg, w_re, b_re, w_gate, w_up, w_down):
    t, d = x2d.shape
    f32 = jnp.float32
    xf = x2d.astype(f32)
    g_logits = xf @ w_rg.astype(f32) + b_rg.astype(f32)
    g_prob = jax.nn.softmax(g_logits, axis=-1)
    g_sel = jnp.argmax(g_logits, axis=-1)
    g_w = jnp.take_along_axis(g_prob, g_sel[:, None], axis=-1)
    e_logits = (xf @ w_re.astype(f32) + b_re.astype(f32)).reshape(t, N_GROUPS, EXPERTS_PER_GROUP)
    e_logits = jnp.take_along_axis(e_logits, g_sel[:, None, None], axis=1)[:, 0]
    top_p, top_i = lax.top_k(jax.nn.softmax(e_logits, axis=-1), TOP_K)
    weights = g_w * top_p / jnp.sum(top_p, axis=-1, keepdims=True)
    expert_id = (g_sel[:, None] * EXPERTS_PER_GROUP + top_i).reshape(-1)
    n_assign = t * TOP_K
    order = jnp.argsort(expert_id)
    sorted_e = expert_id[order]
    counts = jnp.bincount(expert_id, length=N_EXPERTS)
    padded = (counts + MOE_BLOCK - 1) // MOE_BLOCK * MOE_BLOCK
    starts = jnp.cumsum(counts) - counts
    pends = jnp.cumsum(padded)
    pstarts = pends - padded
    dest = pstarts[sorted_e] + jnp.arange(n_assign) - starts[sorted_e]
    n_blocks = -(-n_assign // MOE_BLOCK) + N_EXPERTS
    tok = order // TOP_K
    buf_tok = jnp.zeros((n_blocks * MOE_BLOCK,), tok.dtype).at[dest].set(tok)
    block_expert = jnp.minimum(
        jnp.searchsorted(pends, jnp.arange(n_blocks) * MOE_BLOCK, side='right'), N_EXPERTS - 1)
    xbuf = x2d[buf_tok].reshape(n_blocks, MOE_BLOCK, d)

    def expert_block(args):
        xb, e = args
        hid = jax.nn.silu(xb @ w_gate[e]) * (xb @ w_up[e])
        return hid @ w_down[e]

    ybuf = lax.map(expert_block, (xbuf, block_expert)).reshape(-1, d)
    w_sorted = weights.reshape(-1)[order].astype(x2d.dtype)
    return jnp.zeros_like(x2d).at[tok].add(w_sorted[:, None] * ybuf[dest])


def setup_inputs(seed: int = 0) -> dict:
    key = jax.random.key(seed)
    ks = jax.random.split(key, 24)
    f32 = jnp.float32

    def nrm(k, shape, scale):
        return jax.random.normal(k, shape, f32) * scale

    col_scale = np.concatenate(
        [np.full((n,), DN_BETA if j in (2, 6) else 1.0, np.float32) for j, n in enumerate(IN_SIZES)])
    return {
        'x': nrm(ks[0], (BATCH, SEQ, D_MODEL), 1.0),
        'emb_ln_g': 1.0 + nrm(ks[1], (D_MODEL,), 0.05),
        'emb_ln_b': nrm(ks[2], (D_MODEL,), 0.02),
        'w_in': nrm(ks[3], (DEPTH, D_MODEL, D_IN), D_MODEL ** -0.5) * jnp.asarray(col_scale),
        'na_rpb': nrm(ks[4], (DEPTH, NA_HEADS, 2 * NA_KH_MAX - 1, 2 * NA_KW - 1), 0.02),
        'hg_lb': 1.0 + nrm(ks[5], (2, DEPTH + 1, HG_WIDTH), 0.1),
        'hg_norm_g': 1.0 + nrm(ks[6], (DEPTH, HG_VWIDTH), 0.05),
        'w_proj_a': nrm(ks[7], (DEPTH, NA_WIDTH, D_MODEL), NA_WIDTH ** -0.5 * DN_BETA),
        'w_proj_b': nrm(ks[8], (DEPTH, HG_VWIDTH, D_MODEL), HG_VWIDTH ** -0.5 * DN_BETA),
        'w_out': nrm(ks[9], (DEPTH, D_MODEL, D_MODEL), D_MODEL ** -0.5 * DN_BETA),
        'ln1_g': 1.0 + nrm(ks[10], (DEPTH, D_MODEL), 0.05),
        'ln1_b': nrm(ks[11], (DEPTH, D_MODEL), 0.02),
        'w_router_group': nrm(ks[12], (DEPTH, D_MODEL, N_GROUPS), D_MODEL ** -0.5),
        'b_router_group': nrm(ks[13], (DEPTH, N_GROUPS), 0.01),
        'w_router_expert': nrm(ks[14], (DEPTH, D_MODEL, N_EXPERTS), D_MODEL ** -0.5),
        'b_router_expert': nrm(ks[15], (DEPTH, N_EXPERTS), 0.01),
        'w_gate': nrm(ks[16], (DEPTH, N_EXPERTS, D_MODEL, D_FF_EXPERT), D_MODEL ** -0.5 * DN_BETA),
        'w_up': nrm(ks[17], (DEPTH, N_EXPERTS, D_MODEL, D_FF_EXPERT), D_MODEL ** -0.5 * DN_BETA),
        'w_down': nrm(ks[18], (DEPTH, N_EXPERTS, D_FF_EXPERT, D_MODEL), D_FF_EXPERT ** -0.5 * DN_BETA),
        'ln2_g': 1.0 + nrm(ks[19], (DEPTH, D_MODEL), 0.05),
        'ln2_b': nrm(ks[20], (DEPTH, D_MODEL), 0.02),
    }


def reference(x, emb_ln_g, emb_ln_b, w_in, na_rpb, hg_lb, hg_norm_g, w_proj_a, w_proj_b, w_out,
              ln1_g, ln1_b, w_router_group, b_router_group, w_router_expert, b_router_expert,
              w_gate, w_up, w_down, ln2_g, ln2_b):
    b, s, d = x.shape
    split_points = np.cumsum(IN_SIZES)[:-1].tolist()
    lb_all = jnp.cumsum(jax.nn.softmax(hg_lb.astype(jnp.float32), axis=1), axis=1)
    h = layer_norm(x, emb_ln_g, emb_ln_b)
    for l in range(DEPTH):
        u = h @ w_in[l]
        (na_q, na_k, na_v, hg_q, hg_ff, hg_fb, hg_i, hg_g, gate_a, gate_b) = jnp.split(u, split_points, axis=-1)
        a = neighbourhood_attention(na_q.reshape(b, s, NA_HEADS, NA_HEAD_DIM),
                                    na_k.reshape(b, s, NA_HEADS, NA_HEAD_DIM),
                                    na_v.reshape(b, s, NA_HEADS, NA_HEAD_DIM), na_rpb[l])
        c = hgrn2_bidirectional(hg_q.reshape(b, s, HG_HEADS, HG_DK),
                                hg_ff.reshape(b, s, HG_HEADS, HG_DK),
                                hg_fb.reshape(b, s, HG_HEADS, HG_DK),
                                hg_i.reshape(b, s, HG_HEADS, HG_DV),
                                hg_g.reshape(b, s, HG_HEADS, HG_DV),
                                lb_all[:, l], hg_norm_g[l])
        merged = jax.nn.sigmoid(gate_a) * (a @ w_proj_a[l]) + jax.nn.sigmoid(gate_b) * (c @ w_proj_b[l])
        h = layer_norm(DN_ALPHA * h + merged @ w_out[l], ln1_g[l], ln1_b[l])
        moe = hierarchical_moe(h.reshape(b * s, d), w_router_group[l], b_router_group[l],
                               w_router_expert[l], b_router_expert[l], w_gate[l], w_up[l], w_down[l])
        h = layer_norm(DN_ALPHA * h + moe.reshape(b, s, d), ln2_g[l], ln2_b[l])
    return h
```

```cpp
#include <hip/hip_runtime.h>
#include <hip/hip_cooperative_groups.h>
#include <cstdio>
namespace cg = cooperative_groups;

#define LAS __attribute__((address_space(3)))
typedef unsigned short bf16_t;
typedef short bf16x8 __attribute__((ext_vector_type(8)));
typedef float f32x4 __attribute__((ext_vector_type(4)));
typedef float f32x2 __attribute__((ext_vector_type(2)));
typedef unsigned u32x4 __attribute__((ext_vector_type(4)));
typedef unsigned u32x2 __attribute__((ext_vector_type(2)));
typedef float f32x16 __attribute__((ext_vector_type(16)));
#define MFMA32(a, b, c) __builtin_amdgcn_mfma_f32_32x32x16_bf16((a), (b), (c), 0, 0, 0)

constexpr int D = 1024, NB = 8, SEQ = 8192, NTOK = NB * SEQ, GW = 64, ROWS = SEQ / GW;
constexpr int NAH = 8, NADH = 64, NAW = 512, KH = 8, KW = 16;
constexpr int HGH = 4, HGD = 128, HGW = 512;
constexpr int DIN = 6144;
constexpr int NE = 32, EPG = 8, NG = 4, DFF = 512;
constexpr float ALPHA = 1.189207115002721f;
constexpr float LN_EPS = 1e-5f, RMS_EPS = 1e-6f;
constexpr int NT = 512;
constexpr int MAXROWS = NTOK * 2 + NE * 256;
constexpr int MAXMT = MAXROWS / 256;

constexpr size_t MiB = 1u << 20;
constexpr size_t WS_BAR = 65536;
constexpr size_t WS_CTRL = 0;
constexpr size_t WS_WT_IN = 1 * MiB, WS_WT_PA = 13 * MiB, WS_WT_PB = 14 * MiB, WS_WT_OUT = 15 * MiB, WS_WT_GU = 17 * MiB, WS_WT_D = 81 * MiB;
constexpr size_t WS_HB = 113 * MiB;
constexpr size_t WS_ANA = 113 * MiB, WS_CHG = 177 * MiB, WS_HID = 113 * MiB;
constexpr size_t WS_U0 = 241 * MiB;
constexpr size_t WS_NAQ = WS_U0, WS_NAK = WS_U0 + 64 * MiB, WS_NAV = WS_U0 + 128 * MiB, WS_HQ = WS_U0 + 192 * MiB, WS_GF = WS_U0 + 256 * MiB,
                 WS_GB = WS_U0 + 320 * MiB, WS_HI = WS_U0 + 384 * MiB, WS_HG = WS_U0 + 448 * MiB, WS_GA = WS_U0 + 512 * MiB, WS_GBT = WS_U0 + 640 * MiB;
constexpr size_t WS_T1 = 241 * MiB, WS_MERGED = 369 * MiB, WS_H1B = 497 * MiB, WS_XG = 625 * MiB, WS_Y = 625 * MiB;
constexpr size_t WS_STATS = 1009 * MiB, WS_TOKE = 1010 * MiB, WS_TOKP = 1011 * MiB, WS_TOKW = 1012 * MiB, WS_END = 1013 * MiB;

struct Params { const float* in[21]; float* out; unsigned char* ws; };

__device__ __forceinline__ int opq(int v) { asm volatile("" : "+v"(v)); return v; }
template <int CTRL> __device__ __forceinline__ float dpp_mov(float x) { return __uint_as_float((unsigned)__builtin_amdgcn_update_dpp(0, (int)__float_as_uint(x), CTRL, 0xF, 0xF, false)); }
__device__ __forceinline__ float row_sum16(float x) {
  x += dpp_mov<0xB1>(x);
  x += dpp_mov<0x4E>(x);
  x += dpp_mov<0x141>(x);
  x += dpp_mov<0x140>(x);
  return x;
}
__device__ __forceinline__ float lane_bcast(float x, int l) { return __uint_as_float((unsigned)__builtin_amdgcn_readlane((int)__float_as_uint(x), l)); }
__device__ __forceinline__ float wave_sum(float v) {
  v = row_sum16(v);
  return (lane_bcast(v, 0) + lane_bcast(v, 16)) + (lane_bcast(v, 32) + lane_bcast(v, 48));
}
__device__ __forceinline__ float half_swap_max(float x) { const auto r = __builtin_amdgcn_permlane32_swap(__float_as_uint(x), __float_as_uint(x), false, false); return fmaxf(__uint_as_float(r[0]), __uint_as_float(r[1])); }
__device__ __forceinline__ float half_swap_sum(float x) { const auto r = __builtin_amdgcn_permlane32_swap(__float_as_uint(x), __float_as_uint(x), false, false); return __uint_as_float(r[0]) + __uint_as_float(r[1]); }
__device__ __forceinline__ float bf2f(unsigned short b) { return __uint_as_float(((unsigned)b) << 16); }
__device__ __forceinline__ unsigned f2bf(float f) { unsigned u = __float_as_uint(f); return (u + 0x7fffu + ((u >> 16) & 1u)) >> 16; }
__device__ __forceinline__ unsigned pk2(float lo, float hi) { return f2bf(lo) | (f2bf(hi) << 16); }
typedef __bf16 bf16x2_t __attribute__((ext_vector_type(2)));
__device__ __forceinline__ unsigned cvt_pk_bf16(float lo, float hi) { const bf16x2_t v = {(__bf16)lo, (__bf16)hi}; return __builtin_bit_cast(unsigned, v); }
__device__ __forceinline__ unsigned pk2h(float lo, float hi) { const _Float16 a = (_Float16)lo, b = (_Float16)hi; return (unsigned)__builtin_bit_cast(unsigned short, a) | ((unsigned)__builtin_bit_cast(unsigned short, b) << 16); }
__device__ __forceinline__ float h2f(unsigned short h) { return (float)__builtin_bit_cast(_Float16, h); }
__device__ __forceinline__ float sigm(float x) { return __builtin_amdgcn_rcpf(1.0f + __expf(-x)); }
__device__ __forceinline__ float silu(float x) { return x * __builtin_amdgcn_rcpf(1.0f + __expf(-x)); }

namespace pg8 {
constexpr int BM = 256, BK = 64, HALF = 128, HTB = HALF * BK * 2, STAGE_BYTES = 8 * HTB, NXCD = 8, WGM = 8;
__host__ __device__ __forceinline__ int lds_byte(int r, int c) { const int st = (r >> 4) * 2 + (c >> 5), rr = r & 15, cc = c & 31, ob = rr * 64 + cc * 2; return st * 1024 + (ob ^ (((ob >> 9) & 1) << 5)); }
__host__ __device__ __forceinline__ void stage_rc(int b, int& R, int& C) { const int st = b / 1024, sb = b % 1024, swz = sb ^ (((sb >> 9) & 1) << 5); R = (st >> 1) * 16 + swz / 64; C = (st & 1) * 32 + (swz % 64) / 2; }
__host__ __device__ __forceinline__ int perm32(int rho) { const int n = rho >> 4, i = rho & 15; return 8 * (i >> 2) + 4 * n + (i & 3); }

struct Unit { int pm, pn, e; };
struct Gemm { const bf16_t* A; const bf16_t* Bt; int K; size_t b_estride; const bf16_t* A2; const bf16_t* B2; int nt1; const int* rowlist; };

struct StaticOrder {
  int nM, nN, nwg, G, c;
  __device__ void init(int M, int N, int G_, int c_) { nM = M / BM; nN = N / BM; nwg = nM * nN; G = G_; c = c_; }
  __device__ bool next(int i, Unit& u) const {
    const long L = (long)i * G + c; if (L >= nwg) return false;
    int wgid = (int)L; { const int q = nwg / NXCD, r = nwg % NXCD, xcd = wgid % NXCD, off = wgid / NXCD; wgid = (xcd < r ? xcd * (q + 1) : r * (q + 1) + (xcd - r) * q) + off; }
    const int nig = WGM * nN, gid = wgid / nig, fm = gid * WGM, gsz = (nM - fm) < WGM ? (nM - fm) : WGM;
    u.pm = fm + ((wgid % nig) % gsz); u.pn = (wgid % nig) / gsz; u.e = 0; return true;
  }
};
struct GroupedOrder {
  const LAS int* le; int nmt, G, c;
  __device__ bool next(int i, Unit& u) const {
    const int x = c & 7, sidx = c >> 3, pm = i * (G >> 2) + (sidx >> 2) * 8 + x; if (pm >= nmt) return false;
    u.pm = pm; u.pn = sidx & 3; u.e = le[i]; return true;
  }
};
constexpr int GEMM_LE_OFF = 131072;
constexpr int GEMM_RL_OFF = 131072 + 1024;

constexpr bool kSP2 = true;
constexpr bool kALIGN = true;
template <class Epi, class Sched, bool DUAL = false, bool GATHER = false, bool SP2 = kSP2, bool ALIGN_EPI = kALIGN>
__device__ __forceinline__ void gemm_phase(LAS unsigned char* lds, const Gemm g, const Sched& S, const Epi& E, int ntiles = 0) {
  const int tid = opq(threadIdx.x), wid = __builtin_amdgcn_readfirstlane(tid >> 6), lane = tid & 63, wr = wid >> 2, wc = wid & 3, fr = lane & 15, fq = lane >> 4;
  const int K = g.K, nt = DUAL ? ntiles : K / BK;
  unsigned voffA[2], voffB[2];
#pragma unroll
  for (int i = 0; i < 2; ++i) { int R, C; stage_rc(tid * 16 + i * 8192, R, C); const int Rb = Epi::PERM ? ((R & ~31) + perm32(R & 31)) : R;
    voffA[i] = (unsigned)(R * K + C) * 2u; voffB[i] = (unsigned)(Rb * K + C) * 2u; }
  const size_t kstep = (size_t)(BK * 2);
  const size_t hstep = (size_t)HALF * K * 2;
  const size_t tstep = 2 * hstep;
  const unsigned ldsw = (unsigned)wid * 1024u;
  const int aoff = lds_byte(wr * 64 + fr, fq * 8), boff = lds_byte(wc * 32 + fr, fq * 8);
#define PG8_SA(b, h) (((b) * 2 + (h)) * HTB)
#define PG8_SB(b, h) ((4 + (b) * 2 + (h)) * HTB)
#define PG8_STAGE(bufoff, gbase, voff) do { _Pragma("unroll") for (int _i = 0; _i < 2; ++_i) \
    __builtin_amdgcn_global_load_lds((const unsigned*)((const char*)(gbase) + (voff)[_i]), (LAS unsigned*)(lds + (bufoff) + ldsw + _i * 8192), 16, 0, 0); } while (0)
#define PG8_LDA(dst, b, h) do { _Pragma("unroll") for (int m = 0; m < 4; ++m) _Pragma("unroll") for (int k = 0; k < 2; ++k) dst[m][k] = *(const LAS bf16x8*)(lds + PG8_SA(b, h) + aoff + m * 2048 + k * 1024); } while (0)
#define PG8_LDB(dst, b, h) do { _Pragma("unroll") for (int n = 0; n < 2; ++n) _Pragma("unroll") for (int k = 0; k < 2; ++k) dst[n][k] = *(const LAS bf16x8*)(lds + PG8_SB(b, h) + boff + n * 2048 + k * 1024); } while (0)
#define PG8_MMA(ai, bj, At, Bt) do { __builtin_amdgcn_s_setprio(1); _Pragma("unroll") for (int m = 0; m < 4; ++m) _Pragma("unroll") for (int n = 0; n < 2; ++n) _Pragma("unroll") for (int k = 0; k < 2; ++k) \
    acc[ai][bj][m][n] = __builtin_amdgcn_mfma_f32_16x16x32_bf16(Bt[n][k], At[m][k], acc[ai][bj][m][n], 0, 0, 0); __builtin_amdgcn_s_setprio(0); } while (0)
#define PG8_WAIT_V(n) asm volatile("s_waitcnt vmcnt(" #n ")" ::: "memory")
#define PG8_WAIT_L(n) asm volatile("s_waitcnt lgkmcnt(" #n ")" ::: "memory")
#define PG8_BAR __builtin_amdgcn_s_barrier()
#define PG8_WV1_(NV) asm volatile("s_cmp_eq_u32 %0, 0\n\ts_cbranch_scc1 .Lwn%=\n\ts_waitcnt vmcnt(" #NV ")\n\ts_branch .Lwd%=\n.Lwn%=:\n\ts_waitcnt vmcnt(8)\n.Lwd%=:" :: "s"(afterepi) : "scc", "memory")
#define PG8_WAIT_V1() do { if constexpr (Epi::NVM >= 32) PG8_WV1_(40); else if constexpr (Epi::NVM >= 16) PG8_WV1_(24); else PG8_WV1_(16); } while (0)
#define PG8_SCHED __builtin_amdgcn_sched_barrier(0)
  Unit cur, nxt; int ui = 0;
  if (!S.next(0, cur)) return;
  f32x4 acc[2][2][4][2];
#pragma unroll
  for (int a = 0; a < 2; ++a)
#pragma unroll
    for (int b = 0; b < 2; ++b)
#pragma unroll
      for (int m = 0; m < 4; ++m)
#pragma unroll
        for (int n = 0; n < 2; ++n) acc[a][b][m][n] = (f32x4){0.f, 0.f, 0.f, 0.f};
  bf16x8 At[4][2], B0[2][2], B1[2][2];
  const char* cA = (const char*)g.A + (size_t)cur.pm * tstep; const char* cB = (const char*)g.Bt + (size_t)cur.e * g.b_estride + (size_t)cur.pn * tstep;
  const char* cA2 = DUAL ? (const char*)g.A2 + (size_t)cur.pm * tstep : cA; const char* cB2 = DUAL ? (const char*)g.B2 + (size_t)cur.pn * tstep : cB;
  unsigned gA[2][2] = {{0u, 0u}, {0u, 0u}};
  int gR[2], gC[2];
#pragma unroll
  for (int i = 0; i < 2; ++i) stage_rc(tid * 16 + i * 8192, gR[i], gC[i]);
#define PG8_ROWS(dst, un) do { _Pragma("unroll") for (int h_ = 0; h_ < 2; ++h_) _Pragma("unroll") for (int i_ = 0; i_ < 2; ++i_) \
    dst[h_][i_] = (unsigned)(g.rowlist[(un).pm * BM + h_ * HALF + gR[i_]] * K + gC[i_]) * 2u; } while (0)
  if constexpr (GATHER) { PG8_ROWS(gA, cur); cA = (const char*)g.A; }
#define PG8_RLV(h_, i_) ((unsigned)(*(const LAS int*)(lds + GEMM_RL_OFF + ((ui + 1) & 1) * 1024 + ((h_) * HALF + gR[i_]) * 4) * K + gC[i_]) * 2u)
  if constexpr (SP2) {
    PG8_STAGE(PG8_SB(0, 0), cB, voffB); PG8_STAGE(PG8_SB(0, 1), cB + hstep, voffB);
    if constexpr (GATHER) { PG8_STAGE(PG8_SA(0, 0), cA, gA[0]); PG8_STAGE(PG8_SA(0, 1), cA, gA[1]); } else { PG8_STAGE(PG8_SA(0, 0), cA, voffA); PG8_STAGE(PG8_SA(0, 1), cA + hstep, voffA); }
    if (wr == 1) PG8_BAR;
    PG8_WAIT_V(2); PG8_BAR;
  } else {
  PG8_STAGE(PG8_SB(0, 0), cB, voffB); if constexpr (GATHER) PG8_STAGE(PG8_SA(0, 0), cA, gA[0]); else PG8_STAGE(PG8_SA(0, 0), cA, voffA);
  PG8_STAGE(PG8_SB(0, 1), cB + hstep, voffB); if constexpr (GATHER) PG8_STAGE(PG8_SA(0, 1), cA, gA[1]); else PG8_STAGE(PG8_SA(0, 1), cA + hstep, voffA);
  if (wr == 1) PG8_BAR;
  PG8_WAIT_V(4); PG8_BAR;
  }
  PG8_STAGE(PG8_SB(1, 0), cB + kstep, voffB); if constexpr (GATHER) PG8_STAGE(PG8_SA(1, 0), cA + kstep, gA[0]); else PG8_STAGE(PG8_SA(1, 0), cA + kstep, voffA);
  PG8_STAGE(PG8_SB(1, 1), cB + hstep + kstep, voffB);
  static_assert(SP2 && ALIGN_EPI, "only this schedule is kept");
  if constexpr (GATHER) PG8_STAGE(PG8_SA(1, 1), cA + kstep, gA[1]); else PG8_STAGE(PG8_SA(1, 1), cA + hstep + kstep, voffA);
  PG8_WAIT_V(8); PG8_BAR;
  for (;;) {
    const bool has_next = S.next(ui + 1, nxt);
    const char* nA = GATHER ? (const char*)g.A : (has_next ? (const char*)g.A + (size_t)nxt.pm * tstep : cA);
    if constexpr (GATHER) {
      if (has_next && wid == 0) __builtin_amdgcn_global_load_lds((const unsigned*)(g.rowlist + nxt.pm * BM) + lane * 4, (LAS unsigned*)(lds + GEMM_RL_OFF + ((ui + 1) & 1) * 1024), 16, 0, 0); }
    const char* nB = has_next ? (const char*)g.Bt + (size_t)nxt.e * g.b_estride + (size_t)nxt.pn * tstep : cB;
    for (int t = 0; t < nt; t += 2) {
      const bool last = (t == nt - 2);
      const char* a1 = (DUAL && t >= g.nt1) ? cA2 + (size_t)(t + 1 - g.nt1) * kstep : cA + (size_t)(t + 1) * kstep;
      const char* a2 = last ? nA : ((DUAL && t + 2 >= g.nt1) ? cA2 + (size_t)(t + 2 - g.nt1) * kstep : cA + (size_t)(t + 2) * kstep);
      const char* b2 = last ? nB : ((DUAL && t + 2 >= g.nt1) ? cB2 + (size_t)(t + 2 - g.nt1) * kstep : cB + (size_t)(t + 2) * kstep);
      const char* a3 = a2 + kstep; const char* b3 = b2 + kstep;
      if constexpr (DUAL) { if (t == g.nt1) E.mid(acc, cur, wr, wc, fr, fq); }
      unsigned vA0[2], vA1[2];
      if constexpr (GATHER) { const bool ln_ = last && has_next; _Pragma("unroll") for (int i_ = 0; i_ < 2; ++i_) { const unsigned n0_ = PG8_RLV(0, i_), n1_ = PG8_RLV(1, i_); vA0[i_] = ln_ ? n0_ : gA[0][i_]; vA1[i_] = ln_ ? n1_ : gA[1][i_]; } }
      if constexpr (SP2) {
      const int afterepi = __builtin_amdgcn_readfirstlane((t == 0 && ui != 0) ? 1 : 0);
      PG8_LDB(B0, 0, 0); PG8_LDB(B1, 0, 1); PG8_SCHED; PG8_LDA(At, 0, 0); if constexpr (GATHER) PG8_STAGE(PG8_SA(1, 1), a1, gA[1]); else PG8_STAGE(PG8_SA(1, 1), a1 + hstep, voffA);
      PG8_WAIT_V1(); PG8_WAIT_L(0); PG8_BAR; PG8_MMA(0, 0, At, B0); PG8_MMA(0, 1, At, B1); PG8_BAR; PG8_SCHED;
      PG8_LDA(At, 0, 1); PG8_STAGE(PG8_SB(0, 0), b2, voffB); PG8_STAGE(PG8_SB(0, 1), b2 + hstep, voffB); if constexpr (GATHER) PG8_STAGE(PG8_SA(0, 0), a2, vA0); else PG8_STAGE(PG8_SA(0, 0), a2, voffA);
      PG8_WAIT_V1(); PG8_WAIT_L(0); PG8_BAR; PG8_MMA(1, 0, At, B0); PG8_MMA(1, 1, At, B1); PG8_BAR; PG8_SCHED;
      PG8_LDB(B0, 1, 0); PG8_LDB(B1, 1, 1); PG8_SCHED; PG8_LDA(At, 1, 0); if constexpr (GATHER) PG8_STAGE(PG8_SA(0, 1), a2, vA1); else PG8_STAGE(PG8_SA(0, 1), a2 + hstep, voffA);
      PG8_WAIT_V1(); PG8_WAIT_L(0); PG8_BAR; PG8_MMA(0, 0, At, B0); PG8_MMA(0, 1, At, B1); PG8_BAR; PG8_SCHED;
      PG8_LDA(At, 1, 1); PG8_STAGE(PG8_SB(1, 0), b3, voffB); PG8_STAGE(PG8_SB(1, 1), b3 + hstep, voffB); if constexpr (GATHER) PG8_STAGE(PG8_SA(1, 0), a3, vA0); else PG8_STAGE(PG8_SA(1, 0), a3, voffA);
      PG8_WAIT_V(8); PG8_WAIT_L(0); PG8_BAR; PG8_MMA(1, 0, At, B0); PG8_MMA(1, 1, At, B1); PG8_BAR; PG8_SCHED;
      } else {
      PG8_LDB(B0, 0, 0); PG8_SCHED; PG8_LDA(At, 0, 0); if constexpr (GATHER) PG8_STAGE(PG8_SA(1, 1), a1, gA[1]); else PG8_STAGE(PG8_SA(1, 1), a1 + hstep, voffA);
      PG8_WAIT_L(8); PG8_BAR; PG8_WAIT_L(0); PG8_MMA(0, 0, At, B0); PG8_BAR; PG8_SCHED;
      PG8_LDB(B1, 0, 1); PG8_STAGE(PG8_SB(0, 0), b2, voffB);
      PG8_BAR; PG8_WAIT_L(0); PG8_MMA(0, 1, At, B1); PG8_BAR;
      PG8_LDA(At, 0, 1); if constexpr (GATHER) PG8_STAGE(PG8_SA(0, 0), a2, vA0); else PG8_STAGE(PG8_SA(0, 0), a2, voffA);
      PG8_BAR; PG8_WAIT_L(0); PG8_MMA(1, 0, At, B0); PG8_BAR; PG8_SCHED;
      PG8_STAGE(PG8_SB(0, 1), b2 + hstep, voffB);
      PG8_WAIT_V(6); PG8_BAR; PG8_MMA(1, 1, At, B1); PG8_BAR;
      PG8_LDB(B0, 1, 0); PG8_SCHED; PG8_LDA(At, 1, 0); if constexpr (GATHER) PG8_STAGE(PG8_SA(0, 1), a2, vA1); else PG8_STAGE(PG8_SA(0, 1), a2 + hstep, voffA);
      PG8_WAIT_L(8); PG8_BAR; PG8_WAIT_L(0); PG8_MMA(0, 0, At, B0); PG8_BAR; PG8_SCHED;
      PG8_LDB(B1, 1, 1); PG8_STAGE(PG8_SB(1, 0), b3, voffB);
      PG8_BAR; PG8_WAIT_L(0); PG8_MMA(0, 1, At, B1); PG8_BAR;
      PG8_LDA(At, 1, 1); if constexpr (GATHER) PG8_STAGE(PG8_SA(1, 0), a3, vA0); else PG8_STAGE(PG8_SA(1, 0), a3, voffA);
      PG8_BAR; PG8_WAIT_L(0); PG8_MMA(1, 0, At, B0); PG8_BAR; PG8_SCHED;
      PG8_STAGE(PG8_SB(1, 1), b3 + hstep, voffB);
      PG8_WAIT_V(6); PG8_BAR; PG8_MMA(1, 1, At, B1); PG8_BAR;
      }
    }
    if constexpr (ALIGN_EPI) { if (wr == 0) PG8_BAR; }
    if (has_next) { if constexpr (GATHER) { unsigned r1_[2] = {PG8_RLV(1, 0), PG8_RLV(1, 1)}; PG8_STAGE(PG8_SA(1, 1), nA + kstep, r1_); } else PG8_STAGE(PG8_SA(1, 1), nA + kstep + hstep, voffA); }
    E(acc, cur, wr, wc, fr, fq);
    if (!has_next) break;
#pragma unroll
    for (int a = 0; a < 2; ++a)
#pragma unroll
      for (int b = 0; b < 2; ++b)
#pragma unroll
        for (int m = 0; m < 4; ++m)
#pragma unroll
          for (int n = 0; n < 2; ++n) acc[a][b][m][n] = (f32x4){0.f, 0.f, 0.f, 0.f};
    if constexpr (GATHER) { _Pragma("unroll") for (int h_ = 0; h_ < 2; ++h_) _Pragma("unroll") for (int i_ = 0; i_ < 2; ++i_) gA[h_][i_] = PG8_RLV(h_, i_); }
    cur = nxt; cA = nA; cB = nB; ++ui;
    if constexpr (ALIGN_EPI) { if (wr == 1) PG8_BAR; }
    if (DUAL) { cA2 = (const char*)g.A2 + (size_t)cur.pm * tstep; cB2 = (const char*)g.B2 + (size_t)cur.pn * tstep; }
  }
  PG8_WAIT_V(0);
  if constexpr (!ALIGN_EPI) { if (wr == 0) PG8_BAR; }
  PG8_BAR;
#undef PG8_ROWS
#undef PG8_RLV
#undef PG8_SA
#undef PG8_SB
#undef PG8_STAGE
#undef PG8_LDA
#undef PG8_LDB
#undef PG8_MMA
#undef PG8_WAIT_V
#undef PG8_WAIT_L
#undef PG8_BAR
#undef PG8_WAIT_V1
#undef PG8_WV1_
#undef PG8_SCHED
}

struct EpiU {
  static constexpr bool PERM = true; static constexpr int NVM = 16;
  unsigned char* ubase; const LAS float* lb;
  __device__ __forceinline__ void run_kb(const f32x4 (&acc)[2][2][4][2], unsigned char* base, int row0, int col0) const {
    bf16_t* KB = (bf16_t*)base;
#pragma unroll
    for (int ai = 0; ai < 2; ++ai)
#pragma unroll
      for (int m = 0; m < 4; ++m) {
        const int t = row0 + ai * HALF + m * 16, tb8 = (t >> 13) * 8, grow = (t >> 6) & 127, c = t & 63;
#pragma unroll
        for (int bj = 0; bj < 2; ++bj) {
          const int kcol = col0 + bj * HALF;
          const f32x4 v0 = acc[ai][bj][m][0], v1 = acc[ai][bj][m][1];
          u32x4 w; w.x = cvt_pk_bf16(v0[0], v0[1]); w.y = cvt_pk_bf16(v0[2], v0[3]); w.z = cvt_pk_bf16(v1[0], v1[1]); w.w = cvt_pk_bf16(v1[2], v1[3]);
          *(u32x4*)(KB + ((size_t)(((tb8 + (kcol >> 6)) * 128 + grow) * 8 + ((kcol & 63) >> 3)) * 64 + c) * 8) = w;
        }
      }
  }
  __device__ __forceinline__ void run_vt(const f32x4 (&acc)[2][2][4][2], unsigned char* base, int row0, int col0) const {
    bf16_t* VT = (bf16_t*)base;
#pragma unroll
    for (int ai = 0; ai < 2; ++ai)
#pragma unroll
      for (int m = 0; m < 4; ++m) {
        const int t = row0 + ai * HALF + m * 16, tb8 = (t >> 13) * 8, grow = (t >> 6) & 127, c = t & 63;
#pragma unroll
        for (int bj = 0; bj < 2; ++bj)
#pragma unroll
          for (int n = 0; n < 2; ++n)
#pragma unroll
            for (int j = 0; j < 4; ++j) {
              const int vcol = col0 + bj * HALF + 4 * n + j;
              VT[((size_t)(((tb8 + (vcol >> 6)) * 128 + grow) * 8 + (c >> 3)) * 64 + (vcol & 63)) * 8 + (c & 7)] = __builtin_bit_cast(unsigned short, (__bf16)acc[ai][bj][m][n][j]);
            }
      }
  }
  __device__ __forceinline__ void run_hit(const f32x4 (&acc)[2][2][4][2], unsigned char* base, int row0, int col0) const {
    bf16_t* HT = (bf16_t*)base;
#pragma unroll
    for (int ai = 0; ai < 2; ++ai)
#pragma unroll
      for (int m = 0; m < 4; ++m) {
        const int t = row0 + ai * HALF + m * 16, tb4 = (t >> 13) * 4, blk = (t >> 6) & 127, pos = t & 63;
#pragma unroll
        for (int bj = 0; bj < 2; ++bj)
#pragma unroll
          for (int n = 0; n < 2; ++n)
#pragma unroll
            for (int j = 0; j < 4; ++j) {
              const int hcol = col0 + bj * HALF + 4 * n + j;
              HT[((size_t)((tb4 + (hcol >> 7)) * 128 + blk) * 128 + (hcol & 127)) * 64 + pos] = __builtin_bit_cast(unsigned short, (__bf16)acc[ai][bj][m][n][j]);
            }
      }
  }
  template <int MODE>
  __device__ __forceinline__ void run(const f32x4 (&acc)[2][2][4][2], unsigned char* base, int ld, int row0, int col0, int lbcol0) const {
    f32x4 lbv[2][2];
    if (MODE == 2) {
#pragma unroll
      for (int bj = 0; bj < 2; ++bj)
#pragma unroll
        for (int n = 0; n < 2; ++n) lbv[bj][n] = *(const LAS f32x4*)(lb + lbcol0 + bj * HALF + 4 * n);
    }
#pragma unroll
    for (int ai = 0; ai < 2; ++ai)
#pragma unroll
      for (int m = 0; m < 4; ++m) {
        unsigned char* rowp = base + ((size_t)(row0 + ai * HALF + m * 16) * ld + col0) * 2;
#pragma unroll
        for (int bj = 0; bj < 2; ++bj) {
          f32x4 v[2] = {acc[ai][bj][m][0], acc[ai][bj][m][1]};
          u32x4 w;
#pragma unroll
          for (int n = 0; n < 2; ++n)
#pragma unroll
            for (int j = 0; j < 4; ++j) {
              float x = v[n][j];
              if (MODE == 1) x = silu(x);
              if (MODE == 2) { const float l = lbv[bj][n][j]; x = __logf(l + (1.f - l) * sigm(x)); }
              if (MODE == 3) x = sigm(x);
              if (MODE == 4) x *= 0.125f * 1.4426950408889634f;
              v[n][j] = x;
            }
          if (MODE == 2) { w.x = pk2h(v[0][0], v[0][1]); w.y = pk2h(v[0][2], v[0][3]); w.z = pk2h(v[1][0], v[1][1]); w.w = pk2h(v[1][2], v[1][3]); }
          else { w.x = cvt_pk_bf16(v[0][0], v[0][1]); w.y = cvt_pk_bf16(v[0][2], v[0][3]); w.z = cvt_pk_bf16(v[1][0], v[1][1]); w.w = cvt_pk_bf16(v[1][2], v[1][3]); }
          *(u32x4*)(rowp + bj * HALF * 2) = w;
        }
      }
  }
  __device__ __forceinline__ void operator()(const f32x4 (&acc)[2][2][4][2], const Unit& u, int wr, int wc, int fr, int fq) const {
    const int pn = u.pn, row0 = u.pm * BM + wr * 64 + fr, cw = wc * 32 + 8 * fq;
    if (pn < 16) {
      const int seg = pn >> 1; unsigned char* base = ubase + (size_t)seg * 64 * MiB; const int col0 = (pn & 1) * 256 + cw;
      if (seg == 0) run<4>(acc, base, 512, row0, col0, 0);
      else if (seg == 1) run_kb(acc, base, row0, col0);
      else if (seg == 2) run_vt(acc, base, row0, col0);
      else if (seg == 6) run_hit(acc, base, row0, col0);
      else if (seg == 3 || seg == 7) run<1>(acc, base, 512, row0, col0, 0);
      else if (seg == 4 || seg == 5) run<2>(acc, base, 512, row0, col0, (seg - 4) * 512 + col0);
      else run<0>(acc, base, 512, row0, col0, 0);
    } else {
      bf16_t* GAp = (bf16_t*)(ubase + 512 * MiB); bf16_t* RHp = (bf16_t*)(ubase + 640 * MiB);
      const int col0 = (pn - 16) * 128 + cw;
#pragma unroll
      for (int ai = 0; ai < 2; ++ai)
#pragma unroll
        for (int m = 0; m < 4; ++m) {
          const size_t ro = (size_t)(row0 + ai * HALF + m * 16) * 1024 + col0;
          float ga[8], rh[8];
#pragma unroll
          for (int n = 0; n < 2; ++n)
#pragma unroll
            for (int j = 0; j < 4; ++j) {
              const float ea = 1.f + __expf(-acc[ai][0][m][n][j]), eb = 1.f + __expf(-acc[ai][1][m][n][j]);
              ga[4 * n + j] = __builtin_amdgcn_rcpf(ea); rh[4 * n + j] = ea * __builtin_amdgcn_rcpf(eb);
            }
          u32x4 w; w.x = cvt_pk_bf16(ga[0], ga[1]); w.y = cvt_pk_bf16(ga[2], ga[3]); w.z = cvt_pk_bf16(ga[4], ga[5]); w.w = cvt_pk_bf16(ga[6], ga[7]);
          *(u32x4*)(GAp + ro) = w;
          w.x = cvt_pk_bf16(rh[0], rh[1]); w.y = cvt_pk_bf16(rh[2], rh[3]); w.z = cvt_pk_bf16(rh[4], rh[5]); w.w = cvt_pk_bf16(rh[6], rh[7]);
          *(u32x4*)(RHp + ro) = w;
        }
    }
  }
};
template <int MODE> struct EpiGate {
  static constexpr bool PERM = true; static constexpr int NVM = 32;
  const bf16_t* G1; const bf16_t* T; bf16_t* O;
  __device__ __forceinline__ void mid(f32x4 (&acc)[2][2][4][2], const Unit& u, int wr, int wc, int fr, int fq) const {
    const int row0 = u.pm * BM + wr * 64 + fr, col0 = u.pn * BM + wc * 32 + 8 * fq;
#pragma unroll
    for (int ai = 0; ai < 2; ++ai) {
      u32x4 rv[4][2];
#pragma unroll
      for (int m = 0; m < 4; ++m)
#pragma unroll
        for (int bj = 0; bj < 2; ++bj) rv[m][bj] = *(const u32x4*)(T + (size_t)(row0 + ai * HALF + m * 16) * D + col0 + bj * HALF);
      asm volatile("" : "+v"(rv[0][0]), "+v"(rv[0][1]), "+v"(rv[1][0]), "+v"(rv[1][1]), "+v"(rv[2][0]), "+v"(rv[2][1]), "+v"(rv[3][0]), "+v"(rv[3][1]));
#pragma unroll
      for (int m = 0; m < 4; ++m)
#pragma unroll
        for (int bj = 0; bj < 2; ++bj)
#pragma unroll
          for (int q = 0; q < 4; ++q) {
            const float r0 = __uint_as_float(rv[m][bj][q] << 16), r1 = __uint_as_float(rv[m][bj][q] & 0xffff0000u);
            if (q < 2) { acc[ai][bj][m][0][2 * q] *= r0; acc[ai][bj][m][0][2 * q + 1] *= r1; }
            else { acc[ai][bj][m][1][2 * q - 4] *= r0; acc[ai][bj][m][1][2 * q - 3] *= r1; }
          }
    }
  }
  __device__ __forceinline__ void operator()(const f32x4 (&acc)[2][2][4][2], const Unit& u, int wr, int wc, int fr, int fq) const {
    const int row0 = u.pm * BM + wr * 64 + fr, col0 = u.pn * BM + wc * 32 + 8 * fq;
#pragma unroll
    for (int ai = 0; ai < 2; ++ai) {
      u32x4 gvv[4][2], tvv[4][2];
#pragma unroll
      for (int m = 0; m < 4; ++m)
#pragma unroll
        for (int bj = 0; bj < 2; ++bj) {
          const size_t ro = (size_t)(row0 + ai * HALF + m * 16) * D + col0 + bj * HALF;
          gvv[m][bj] = *(const u32x4*)(G1 + ro);
          if constexpr (MODE == 1) tvv[m][bj] = *(const u32x4*)(T + ro);
        }
      asm volatile("" : "+v"(gvv[0][0]), "+v"(gvv[0][1]), "+v"(gvv[1][0]), "+v"(gvv[1][1]), "+v"(gvv[2][0]), "+v"(gvv[2][1]), "+v"(gvv[3][0]), "+v"(gvv[3][1]));
#pragma unroll
      for (int m = 0; m < 4; ++m)
#pragma unroll
        for (int bj = 0; bj < 2; ++bj) {
          const size_t ro = (size_t)(row0 + ai * HALF + m * 16) * D + col0 + bj * HALF;
          const u32x4 gv = gvv[m][bj]; u32x4 tv = (u32x4){0u, 0u, 0u, 0u}; if constexpr (MODE == 1) tv = tvv[m][bj];
          const f32x4 v0 = acc[ai][bj][m][0], v1 = acc[ai][bj][m][1];
          const float a8[8] = {v0[0], v0[1], v0[2], v0[3], v1[0], v1[1], v1[2], v1[3]};
          float o[8];
#pragma unroll
          for (int q = 0; q < 4; ++q) {
            const float g0 = __uint_as_float(gv[q] << 16), g1 = __uint_as_float(gv[q] & 0xffff0000u);
            float r0 = g0 * a8[2 * q], r1 = g1 * a8[2 * q + 1];
            if (MODE == 1) { r0 += __uint_as_float(tv[q] << 16); r1 += __uint_as_float(tv[q] & 0xffff0000u); }
            o[2 * q] = r0; o[2 * q + 1] = r1;
          }
          u32x4 w; w.x = cvt_pk_bf16(o[0], o[1]); w.y = cvt_pk_bf16(o[2], o[3]); w.z = cvt_pk_bf16(o[4], o[5]); w.w = cvt_pk_bf16(o[6], o[7]);
          *(u32x4*)(O + ro) = w;
        }
    }
  }
};
struct EpiRes {
  static constexpr bool PERM = true; static constexpr int NVM = 16;
  const float* x; const float* stats; const float* g; const float* b; float* O;
  __device__ __forceinline__ void operator()(const f32x4 (&acc)[2][2][4][2], const Unit& u, int wr, int wc, int fr, int fq) const {
    const int row0 = u.pm * BM + wr * 64 + fr, col0 = u.pn * BM + wc * 32 + 8 * fq;
    f32x4 gv[2][2], bv[2][2];
#pragma unroll
    for (int bj = 0; bj < 2; ++bj)
#pragma unroll
      for (int n = 0; n < 2; ++n) { gv[bj][n] = *(const f32x4*)(g + col0 + bj * HALF + n * 4) * ALPHA; bv[bj][n] = *(const f32x4*)(b + col0 + bj * HALF + n * 4) * ALPHA; }
#pragma unroll
    for (int ai = 0; ai < 2; ++ai)
#pragma unroll
      for (int m = 0; m < 4; ++m) {
        const int r = row0 + ai * HALF + m * 16; const f32x2 st = *(const f32x2*)(stats + 2 * (size_t)r);
        const size_t ro = (size_t)r * D + col0;
#pragma unroll
        for (int bj = 0; bj < 2; ++bj)
#pragma unroll
          for (int n = 0; n < 2; ++n) {
            const f32x4 xv = *(const f32x4*)(x + ro + bj * HALF + n * 4);
            *(f32x4*)(O + ro + bj * HALF + n * 4) = ((xv - st.x) * st.y) * gv[bj][n] + bv[bj][n] + acc[ai][bj][m][n];
          }
      }
  }
};
struct EpiSwiGLU {
  static constexpr bool PERM = true; static constexpr int NVM = 8;
  bf16_t* HID;
  __device__ __forceinline__ void operator()(const f32x4 (&acc)[2][2][4][2], const Unit& u, int wr, int wc, int fr, int fq) const {
    const int row0 = u.pm * BM + wr * 64 + fr, col0 = u.pn * 128 + wc * 32 + 8 * fq;
#pragma unroll
    for (int ai = 0; ai < 2; ++ai)
#pragma unroll
      for (int m = 0; m < 4; ++m) {
        float o[8];
#pragma unroll
        for (int n = 0; n < 2; ++n)
#pragma unroll
          for (int j = 0; j < 4; ++j) o[4 * n + j] = silu(acc[ai][0][m][n][j]) * acc[ai][1][m][n][j];
        u32x4 w; w.x = cvt_pk_bf16(o[0], o[1]); w.y = cvt_pk_bf16(o[2], o[3]); w.z = cvt_pk_bf16(o[4], o[5]); w.w = cvt_pk_bf16(o[6], o[7]);
        *(u32x4*)(HID + (size_t)(row0 + ai * HALF + m * 16) * DFF + col0) = w;
      }
  }
};
struct EpiBf16 {
  static constexpr bool PERM = true; static constexpr int NVM = 16;
  bf16_t* O; int ldc;
  __device__ __forceinline__ void operator()(const f32x4 (&acc)[2][2][4][2], const Unit& u, int wr, int wc, int fr, int fq) const {
    const int row0 = u.pm * BM + wr * 64 + fr, col0 = u.pn * BM + wc * 32 + 8 * fq;
#pragma unroll
    for (int ai = 0; ai < 2; ++ai)
#pragma unroll
      for (int m = 0; m < 4; ++m) {
        bf16_t* rowp = O + (size_t)(row0 + ai * HALF + m * 16) * ldc + col0;
#pragma unroll
        for (int bj = 0; bj < 2; ++bj) {
          const f32x4 v0 = acc[ai][bj][m][0], v1 = acc[ai][bj][m][1];
          u32x4 w; w.x = cvt_pk_bf16(v0[0], v0[1]); w.y = cvt_pk_bf16(v0[2], v0[3]); w.z = cvt_pk_bf16(v1[0], v1[1]); w.w = cvt_pk_bf16(v1[2], v1[3]);
          *(u32x4*)(rowp + bj * HALF) = w;
        }
      }
  }
};
}

__device__ __forceinline__ void p0_transpose_item(const float* W, int K, int N, bf16_t* WT, int k0, int n0, int drow0, LAS float* scr, int lane) {
  f32x4 v[8];
#pragma unroll
  for (int i = 0; i < 8; ++i) v[i] = *(const f32x4*)(W + (size_t)(k0 + (lane >> 3) + 8 * i) * N + n0 + (lane & 7) * 4);
#pragma unroll
  for (int i = 0; i < 8; ++i) { LAS float* d = scr + ((lane >> 3) + 8 * i) * 33 + (lane & 7) * 4; d[0] = v[i].x; d[1] = v[i].y; d[2] = v[i].z; d[3] = v[i].w; }
  asm volatile("s_waitcnt lgkmcnt(0)" ::: "memory");
  const int c = lane & 7;
#pragma unroll
  for (int j = 0; j < 4; ++j) { const int n = (lane >> 3) + 8 * j; const LAS float* s = scr + (8 * c) * 33 + n;
    u32x4 o; o.x = pk2(s[0 * 33], s[1 * 33]); o.y = pk2(s[2 * 33], s[3 * 33]); o.z = pk2(s[4 * 33], s[5 * 33]); o.w = pk2(s[6 * 33], s[7 * 33]);
    *(u32x4*)(WT + (size_t)(drow0 + n) * K + k0 + 8 * c) = o; }
  asm volatile("s_waitcnt lgkmcnt(0)" ::: "memory");
}

struct P0Ptrs { const float *w_in, *wpa, *wpb, *w_out, *w_gate, *w_up, *w_down; bf16_t *WT_in, *WT_pa, *WT_pb, *WT_out, *WT_gu, *WT_d; };
__device__ __forceinline__ void p0_decode(const P0Ptrs& P, int it, const float*& src, int& N_, bf16_t*& dst, int& K_) {
  constexpr int I_IN = (D / 64) * (DIN / 32), I_PA = (NAW / 64) * (D / 32), I_OUT = (D / 64) * (D / 32), I_GU = (D / 64) * (DFF / 32), I_DN = (DFF / 64) * (D / 32);
  int r = it;
  if (r < I_IN) { const int nb = DIN / 32, kb = r / nb, n0 = (r % nb) * 32;
    int drow = n0; if (n0 >= 4096) { const int j0 = (n0 - 4096) & 1023; drow = 4096 + (j0 >> 7) * 256 + (n0 >= 5120 ? 128 : 0) + (j0 & 127); }
    src = P.w_in + (size_t)(kb * 64) * DIN + n0; N_ = DIN; dst = P.WT_in + (size_t)drow * D + kb * 64; K_ = D; return; } r -= I_IN;
  if (r < I_PA) { const int nb = D / 32, kb = r / nb, n0 = (r % nb) * 32; src = P.wpa + (size_t)(kb * 64) * D + n0; N_ = D; dst = P.WT_pa + (size_t)n0 * NAW + kb * 64; K_ = NAW; return; } r -= I_PA;
  if (r < I_PA) { const int nb = D / 32, kb = r / nb, n0 = (r % nb) * 32; src = P.wpb + (size_t)(kb * 64) * D + n0; N_ = D; dst = P.WT_pb + (size_t)n0 * HGW + kb * 64; K_ = HGW; return; } r -= I_PA;
  if (r < I_OUT) { const int nb = D / 32, kb = r / nb, n0 = (r % nb) * 32; src = P.w_out + (size_t)(kb * 64) * D + n0; N_ = D; dst = P.WT_out + (size_t)n0 * D + kb * 64; K_ = D; return; } r -= I_OUT;
  const int e = r / (2 * I_GU + I_DN); r -= e * (2 * I_GU + I_DN);
  if (r < 2 * I_GU) {
    const int up = r >= I_GU; if (up) r -= I_GU;
    const int nb = DFF / 32, kb = r / nb, n0 = (r % nb) * 32;
    src = (up ? P.w_up : P.w_gate) + (size_t)e * D * DFF + (size_t)(kb * 64) * DFF + n0; N_ = DFF;
    dst = P.WT_gu + (size_t)(e * 1024 + (n0 >> 7) * 256 + up * 128 + (n0 & 127)) * D + kb * 64; K_ = D;
  } else { r -= 2 * I_GU; const int nb = D / 32, kb = r / nb, n0 = (r % nb) * 32;
    src = P.w_down + (size_t)e * DFF * D + (size_t)(kb * 64) * D + n0; N_ = D; dst = P.WT_d + (size_t)(e * 1024 + n0) * DFF + kb * 64; K_ = DFF; }
}

constexpr int SC_QP = 0;
constexpr int SC_KP = SC_QP + 64 * 272;
constexpr int SC_KT = SC_KP + 64 * 272;
constexpr int SC_VT = SC_KT + 128 * 144;
constexpr int SC_A = SC_VT + 128 * 144;
constexpr int SC_ST = SC_A + 64 * 144;
constexpr int SC_EB = SC_ST + 128 * 272;
constexpr int SC_TOT = SC_EB + 512;
constexpr int SC_END = SC_TOT + 4096;
static_assert(SC_END <= 131072, "scan LDS map");
__device__ __forceinline__ bf16x8 ldfrag(LAS unsigned char* base, int stride, int row, int kel) { return *(const LAS bf16x8*)(base + row * stride + kel * 2); }


#define XB_TMO      128
#define XB_XCNT(j)  (256  + 64 * (j))
#define XB_XSUB(j)  (1280 + 64 * (j))
#define XB_XGEN(j)  (2304 + 64 * (j))
#define XB_TOP      3328
#define XB_TOPGEN   3392
#define XCD_BAR_WORDS 3456
#define XB_SPIN_CAP (1u << 20)
__device__ __forceinline__ unsigned xb_ld(unsigned* p)              { return __hip_atomic_load(p, __ATOMIC_RELAXED, __HIP_MEMORY_SCOPE_AGENT); }
__device__ __forceinline__ unsigned xb_add(unsigned* p, unsigned v) { return __hip_atomic_fetch_add(p, v, __ATOMIC_RELAXED, __HIP_MEMORY_SCOPE_AGENT); }
__device__ __forceinline__ unsigned xb_xcc_id() { return (unsigned)__builtin_amdgcn_s_getreg((3 << 11) | 20) & 0xFu; }
#define XB_SPIN(cond, bar) do { unsigned _sp = 0; while (cond) { __builtin_amdgcn_s_sleep(1); \
    if ((++_sp & 255u) == 0u) { if (xb_ld(&(bar)[XB_TMO])) break; if (_sp > XB_SPIN_CAP) { atomicAdd(&(bar)[XB_TMO], 1u); break; } } } } while (0)
struct XcdBarrier { unsigned* bar; unsigned x; volatile LAS unsigned* st; };
__device__ __forceinline__ XcdBarrier xcd_barrier_post(unsigned* bar, volatile LAS unsigned* st) {
  XcdBarrier b; b.bar = bar; b.x = xb_xcc_id(); b.st = st;
  if (threadIdx.x == 0) (void)xb_add(&bar[XB_XCNT(b.x)], 1u);
  return b;
}
__device__ __forceinline__ void xcd_barrier_complete(unsigned* bar, unsigned x, unsigned& nloc, unsigned& nx) {
  const unsigned G = gridDim.x * gridDim.y * gridDim.z;
  unsigned sum, cnt, mine, sp = 0u;
  for (;;) {
    sum = 0u; cnt = 0u; mine = 0u;
#pragma unroll
    for (unsigned j = 0; j < 16; ++j) { const unsigned c = xb_ld(&bar[XB_XCNT(j)]); sum += c; cnt += (c > 0u) ? 1u : 0u; mine = (j == x) ? c : mine; }
    if (sum == G) break;
    __builtin_amdgcn_s_sleep(1);
    if ((++sp & 255u) == 0u) { if (xb_ld(&bar[XB_TMO])) break; if (sp > XB_SPIN_CAP) { atomicAdd(&bar[XB_TMO], 1u); break; } }
  }
  nloc = mine > 0u ? mine : 1u; nx = cnt > 0u ? cnt : 1u;
}
__device__ __forceinline__ void xcd_barrier(const XcdBarrier& b) {
  asm volatile("s_waitcnt vmcnt(0)" ::: "memory");
  __syncthreads();
  if (threadIdx.x == 0) {
    unsigned* bar = b.bar;
    __builtin_amdgcn_s_waitcnt(0);
    unsigned nloc = b.st[0], nx = b.st[1];
    if (nloc == 0u) { xcd_barrier_complete(bar, b.x, nloc, nx); b.st[0] = nloc; b.st[1] = nx; }
    const unsigned old = xb_add(&bar[XB_XSUB(b.x)], 1u);
    const unsigned gen = old / nloc;
    if (old + 1u == (gen + 1u) * nloc) {
      __builtin_amdgcn_fence(__ATOMIC_RELEASE, "agent");
      asm volatile("s_waitcnt vmcnt(0)" ::: "memory");
      const unsigned og = xb_add(&bar[XB_TOP], 1u);
      const unsigned tg = og / nx;
      if (og + 1u == (tg + 1u) * nx) xb_add(&bar[XB_TOPGEN], 1u);
      else XB_SPIN(xb_ld(&bar[XB_TOPGEN]) == tg, bar);
      __builtin_amdgcn_fence(__ATOMIC_ACQUIRE, "agent");
      xb_add(&bar[XB_XGEN(b.x)], 1u);
      asm volatile("s_waitcnt vmcnt(0)" ::: "memory");
    } else {
      XB_SPIN(xb_ld(&bar[XB_XGEN(b.x)]) == gen, bar);
      __builtin_amdgcn_fence(__ATOMIC_ACQUIRE, "agent");
      asm volatile("s_waitcnt vmcnt(0)" ::: "memory");
    }
  }
  __syncthreads();
}

constexpr int LDS_BYTES = 157696;
__global__ void __launch_bounds__(NT, 2) fwd_megakernel(Params p) {
  cg::grid_group grid = cg::this_grid();
  extern __shared__ __attribute__((aligned(16))) unsigned char lds_raw[];
  LAS unsigned char* lds = (LAS unsigned char*)lds_raw;
  const int G = gridDim.x, bid = blockIdx.x, NGW = G * (NT / 64);
  volatile LAS unsigned* bst = (volatile LAS unsigned*)(lds + LDS_BYTES - 16);
  if (threadIdx.x < 4) bst[threadIdx.x] = 0u;
  __syncthreads();
  if (bid == 0) for (int i = threadIdx.x; i < 4096; i += NT) __hip_atomic_store((unsigned*)(p.ws + WS_BAR) + i, 0u, __ATOMIC_RELAXED, __HIP_MEMORY_SCOPE_AGENT);
#define GRID_BAR() xcd_barrier(xbar)
#define PHASE_IDS const int tid = opq(threadIdx.x), lane = tid & 63, wid = tid >> 6, gw = bid * (NT / 64) + wid; (void)lane; (void)gw; (void)wid;

  const float* x = p.in[0];
  const float *emb_g = p.in[1], *emb_b = p.in[2], *w_in = p.in[3], *rpb = p.in[4], *hg_lb = p.in[5], *hg_ng = p.in[6];
  const float *wpa = p.in[7], *wpb = p.in[8], *w_out = p.in[9], *ln1_g = p.in[10], *ln1_b = p.in[11];
  const float *w_rg = p.in[12], *b_rg = p.in[13], *w_re = p.in[14], *b_re = p.in[15];
  const float *w_gate = p.in[16], *w_up = p.in[17], *w_down = p.in[18], *ln2_g = p.in[19], *ln2_b = p.in[20];
  unsigned char* ws = p.ws;
  int* cnt = (int*)(ws + WS_CTRL); int* offs = (int*)(ws + WS_CTRL + 256); int* nmt_p = (int*)(ws + WS_CTRL + 512); int* tile_e = (int*)(ws + WS_CTRL + 1024);
  float* lb = (float*)(ws + WS_CTRL + 8192); int* blk_base = (int*)(ws + WS_CTRL + 32768);
  bf16_t* WT_in = (bf16_t*)(ws + WS_WT_IN); bf16_t* WT_pa = (bf16_t*)(ws + WS_WT_PA); bf16_t* WT_pb = (bf16_t*)(ws + WS_WT_PB); bf16_t* WT_out = (bf16_t*)(ws + WS_WT_OUT);
  bf16_t* WT_gu = (bf16_t*)(ws + WS_WT_GU); bf16_t* WT_d = (bf16_t*)(ws + WS_WT_D);
  bf16_t* hb = (bf16_t*)(ws + WS_HB); bf16_t* hid = (bf16_t*)(ws + WS_HID);
  bf16_t* a_na = (bf16_t*)((unsigned char*)p.out + 128 * MiB); bf16_t* c_hg = (bf16_t*)((unsigned char*)p.out + 192 * MiB);
  bf16_t* NAQ = (bf16_t*)(ws + WS_NAQ); bf16_t* NAK = (bf16_t*)(ws + WS_NAK); bf16_t* NAV = (bf16_t*)(ws + WS_NAV); bf16_t* HQ = (bf16_t*)(ws + WS_HQ);
  bf16_t* GF = (bf16_t*)(ws + WS_GF); bf16_t* GBW = (bf16_t*)(ws + WS_GB); bf16_t* HI = (bf16_t*)(ws + WS_HI); bf16_t* HG = (bf16_t*)(ws + WS_HG);
  bf16_t* GA = (bf16_t*)(ws + WS_GA); bf16_t* GBT = (bf16_t*)(ws + WS_GBT);
  int* srt = (int*)(ws + WS_XG);
  bf16_t* T1 = (bf16_t*)(ws + WS_T1); bf16_t* merged = (bf16_t*)(ws + WS_MERGED); bf16_t* h1b = (bf16_t*)(ws + WS_H1B); bf16_t* xg = (bf16_t*)(ws + WS_XG); bf16_t* ybuf = (bf16_t*)(ws + WS_Y);
  int* tok_e = (int*)(ws + WS_TOKE); int* tok_p = (int*)(ws + WS_TOKP); float* tok_w = (float*)(ws + WS_TOKW);
  float* Sloc = (float*)c_hg;
  float* Dtot = (float*)((unsigned char*)c_hg + 16 * MiB);
  bf16_t* obf = (bf16_t*)p.out; bf16_t* obb = (bf16_t*)p.out + (size_t)NTOK * HGW; float* h1 = p.out;

  { PHASE_IDS
    if (bid == 0 && tid < NE) cnt[tid] = 0;
    for (int i = bid * NT + tid; i < 2 * HGW; i += G * NT) {
      const int dir = i / HGW, c = i % HGW;
      const float v0 = hg_lb[dir * 2 * HGW + c], v1 = hg_lb[dir * 2 * HGW + HGW + c];
      const float m = fmaxf(v0, v1), e0 = expf(v0 - m), e1 = expf(v1 - m);
      lb[i] = e0 / (e0 + e1);
    }
    LAS float* scr = (LAS float*)(lds + wid * 16384);
    constexpr int I_IN = (D / 64) * (DIN / 32), I_PA = (NAW / 64) * (D / 32), I_OUT = (D / 64) * (D / 32), I_GU = (D / 64) * (DFF / 32), I_DN = (DFF / 64) * (D / 32);
    constexpr int NITEMS = I_IN + 2 * I_PA + I_OUT + NE * (2 * I_GU + I_DN);
    {
      const P0Ptrs PP{w_in, wpa, wpb, w_out, w_gate, w_up, w_down, WT_in, WT_pa, WT_pb, WT_out, WT_gu, WT_d};
      f32x4 gq4[4], bq4[4];
#pragma unroll
      for (int j = 0; j < 4; ++j) { gq4[j] = ((const f32x4*)emb_g)[lane + 64 * j]; bq4[j] = ((const f32x4*)emb_b)[lane + 64 * j]; }
      f32x4 xn[2][4], wn[8]; bf16_t* dstn = nullptr; int Kn_ = 0;
#define P0_LOADX(t_) do { const f32x4* xr_ = (const f32x4*)(x + (size_t)(t_) * D) + lane; \
        _Pragma("unroll") for (int rr = 0; rr < 2; ++rr) _Pragma("unroll") for (int j = 0; j < 4; ++j) xn[rr][j] = xr_[rr * (D / 4) + 64 * j]; } while (0)
#define P0_LOADW(it_) do { const float* src_; int N_; p0_decode(PP, (it_), src_, N_, dstn, Kn_); \
        _Pragma("unroll") for (int i = 0; i < 8; ++i) wn[i] = *(const f32x4*)(src_ + (size_t)((lane >> 3) + 8 * i) * N_ + (lane & 7) * 4); } while (0)
      constexpr int NSTEP = NTOK / 2 / 2048;
      P0_LOADX(2 * gw); if (gw < NITEMS) P0_LOADW(gw);
#pragma unroll 1
      for (int k = 0; k < NSTEP; ++k) {
        const int t = 2 * gw + k * 2 * NGW, it = gw + k * NGW;
        f32x4 v[2][4], wv[8]; bf16_t* dst = dstn; const int K_ = Kn_;
#pragma unroll
        for (int rr = 0; rr < 2; ++rr)
#pragma unroll
          for (int j = 0; j < 4; ++j) v[rr][j] = xn[rr][j];
#pragma unroll
        for (int i = 0; i < 8; ++i) wv[i] = wn[i];
        if (k + 1 < NSTEP) { P0_LOADX(t + 2 * NGW); if (it + NGW < NITEMS) P0_LOADW(it + NGW); }
        float s0 = 0.f, s1 = 0.f;
#pragma unroll
        for (int j = 0; j < 4; ++j) { s0 += (v[0][j].x + v[0][j].y) + (v[0][j].z + v[0][j].w); s1 += (v[1][j].x + v[1][j].y) + (v[1][j].z + v[1][j].w); }
        const float mean0 = wave_sum(s0) * (1.f / D), mean1 = wave_sum(s1) * (1.f / D);
        float q0 = 0.f, q1 = 0.f;
#pragma unroll
        for (int j = 0; j < 4; ++j) { v[0][j] = v[0][j] - mean0; v[1][j] = v[1][j] - mean1;
          q0 += (v[0][j].x * v[0][j].x + v[0][j].y * v[0][j].y) + (v[0][j].z * v[0][j].z + v[0][j].w * v[0][j].w);
          q1 += (v[1][j].x * v[1][j].x + v[1][j].y * v[1][j].y) + (v[1][j].z * v[1][j].z + v[1][j].w * v[1][j].w); }
        const float rstd0 = rsqrtf(wave_sum(q0) * (1.f / D) + LN_EPS), rstd1 = rsqrtf(wave_sum(q1) * (1.f / D) + LN_EPS);
        u32x2* o8 = (u32x2*)(hb + (size_t)t * D) + lane;
#pragma unroll
        for (int j = 0; j < 4; ++j) {
          const f32x4 oa = v[0][j] * rstd0 * gq4[j] + bq4[j], ob_ = v[1][j] * rstd1 * gq4[j] + bq4[j];
          u32x2 wa; wa.x = cvt_pk_bf16(oa.x, oa.y); wa.y = cvt_pk_bf16(oa.z, oa.w); o8[64 * j] = wa;
          u32x2 wb; wb.x = cvt_pk_bf16(ob_.x, ob_.y); wb.y = cvt_pk_bf16(ob_.z, ob_.w); o8[D / 4 + 64 * j] = wb;
        }
        if (it < NITEMS) {
#pragma unroll
          for (int i = 0; i < 8; ++i) { LAS float* d = scr + ((lane >> 3) + 8 * i) * 33 + (lane & 7) * 4; d[0] = wv[i].x; d[1] = wv[i].y; d[2] = wv[i].z; d[3] = wv[i].w; }
          asm volatile("s_waitcnt lgkmcnt(0)" ::: "memory");
          const int c = lane & 7;
#pragma unroll
          for (int j = 0; j < 4; ++j) { const int n = (lane >> 3) + 8 * j; const LAS float* sp = scr + (8 * c) * 33 + n;
            u32x4 o; o.x = cvt_pk_bf16(sp[0 * 33], sp[1 * 33]); o.y = cvt_pk_bf16(sp[2 * 33], sp[3 * 33]); o.z = cvt_pk_bf16(sp[4 * 33], sp[5 * 33]); o.w = cvt_pk_bf16(sp[6 * 33], sp[7 * 33]);
            *(u32x4*)(dst + (size_t)n * K_ + 8 * c) = o; }
          asm volatile("s_waitcnt lgkmcnt(0)" ::: "memory");
        }
      }
#undef P0_LOADX
#undef P0_LOADW
    }
  }
  grid.sync();
  XcdBarrier xbar = xcd_barrier_post((unsigned*)(p.ws + WS_BAR), bst);
  {
    pg8::Gemm g{hb, WT_in, D, 0}; pg8::StaticOrder S; S.init(NTOK, DIN, G, bid);
    { LAS float* lbl = (LAS float*)(lds + 131072 + 4096); for (int i = threadIdx.x; i < 2 * HGW; i += NT) lbl[i] = lb[i]; __syncthreads(); }
    pg8::EpiU E{ws + WS_U0, (const LAS float*)(lds + 131072 + 4096)};
    pg8::gemm_phase(lds, g, S, E);
  }
  GRID_BAR();
  { PHASE_IDS
    const int w = __builtin_amdgcn_readfirstlane(wid);
    const int seq = bid >> 2, sg = bid & 3, b = seq >> 3, dir = (seq >> 2) & 1, head = seq & 3;
    const bf16_t* Gp = dir ? GBW : GF; bf16_t* ob = dir ? obb : obf;
    const size_t t0 = (size_t)b * SEQ;
    const int hh = lane >> 5, r = lane & 31;
    constexpr float LOG2E = 1.4426950408889634f;
    for (int i = tid; i < 128 * 272 / 4; i += NT) ((LAS unsigned*)(lds + SC_ST))[i] = 0u;
    f32x16 s0, s1, oacc;
#pragma unroll
    for (int i = 0; i < 16; ++i) { s0[i] = 0.f; s1[i] = 0.f; }
    const int kbS = w >> 1, vbS = 2 * (w & 1), ibO = w >> 2, vbO = w & 3;
    float bsum0 = 0.f, bsum1 = 0.f;
    unsigned gq[8], gg[8]; u32x4 gv0, gv1;
    const int vrow = tid >> 2, vpart = tid & 3;
    const int coff = head * HGD + 2 * lane;
    const bf16_t* VTg = HI + (size_t)((b * 4 + head) * 128) * 128 * 64;
#define SC_TOK(c_, i_) (dir ? (SEQ - 1 - ((c_) * 64 + (i_))) : ((c_) * 64 + (i_)))
#define SC_LOAD(c_, Q_, G_, V0_, V1_) do { const size_t tb_ = (t0 + SC_TOK(c_, 8 * w)) * HGW + coff; const bf16_t* qb_ = HQ + tb_; const bf16_t* gb_ = Gp + tb_; \
      if (dir) { _Pragma("unroll") for (int e = 0; e < 8; ++e) { Q_[e] = *(const unsigned*)(qb_ - e * HGW); G_[e] = *(const unsigned*)(gb_ - e * HGW); } } \
      else { _Pragma("unroll") for (int e = 0; e < 8; ++e) { Q_[e] = *(const unsigned*)(qb_ + e * HGW); G_[e] = *(const unsigned*)(gb_ + e * HGW); } } \
      { const bf16_t* vp_ = VTg + ((size_t)((dir ? 127 - (c_) : (c_)) * 128 + vrow)) * 64 + vpart * 16; V0_ = *(const u32x4*)vp_; V1_ = *(const u32x4*)(vp_ + 8); } } while (0)
    unsigned gqB[8], ggB[8]; u32x4 gv0B, gv1B;
    SC_LOAD(32 * sg, gq, gg, gv0, gv1); SC_LOAD(32 * sg + 1, gqB, ggB, gv0B, gv1B);
    auto sc_chunk = [&](const int c, unsigned (&Q_)[8], unsigned (&G_)[8], u32x4& V0_, u32x4& V1_) __attribute__((always_inline)) {
      const int cg_ = 32 * sg + c;
      float c0[8], c1[8], l0[8], l1[8];
      {
        float a0 = 0.f, a1 = 0.f;
#pragma unroll
        for (int e = 0; e < 8; ++e) {
          l0[e] = h2f((unsigned short)(G_[e] & 0xffffu)) * LOG2E; l1[e] = h2f((unsigned short)(G_[e] >> 16)) * LOG2E;
          a0 += l0[e]; a1 += l1[e]; c0[e] = a0; c1[e] = a1;
        }
        *(LAS f32x2*)(lds + SC_TOT + (w * 128 + 2 * lane) * 4) = (f32x2){a0, a1};
      }
      __syncthreads();
      float off0 = 0.f, off1 = 0.f, bl0 = 0.f, bl1 = 0.f;
#pragma unroll
      for (int w2 = 0; w2 < 8; ++w2) {
        const f32x2 tv = *(const LAS f32x2*)(lds + SC_TOT + (w2 * 128 + 2 * lane) * 4);
        bl0 += tv.x; bl1 += tv.y; if (w2 < w) { off0 += tv.x; off1 += tv.y; }
      }
      bsum0 += bl0; bsum1 += bl1;
      const float eb0 = __builtin_amdgcn_exp2f(bl0), eb1 = __builtin_amdgcn_exp2f(bl1);
      if (w == 0) *(LAS f32x2*)(lds + SC_EB + 2 * lane * 4) = (f32x2){eb0, eb1};
      {
        float kp0[8], kp1[8];
#pragma unroll
        for (int e = 0; e < 8; ++e) {
          const float B0 = off0 + c0[e], B1 = off1 + c1[e];
          const float q0 = __uint_as_float(Q_[e] << 16), q1 = __uint_as_float(Q_[e] & 0xffff0000u);
          const float k0 = 1.f - __builtin_amdgcn_exp2f(l0[e]), k1 = 1.f - __builtin_amdgcn_exp2f(l1[e]);
          const float e0 = __builtin_amdgcn_exp2f(B0), e1 = __builtin_amdgcn_exp2f(B1);
          const float qp0 = q0 * e0, qp1 = q1 * e1;
          const float kq0 = k0 * __builtin_amdgcn_rcpf(e0), kq1 = k1 * __builtin_amdgcn_rcpf(e1);
          kp0[e] = kq0 * eb0; kp1[e] = kq1 * eb1;
          const int i = 8 * w + e;
          *(LAS unsigned*)(lds + SC_QP + i * 272 + lane * 4) = cvt_pk_bf16(qp0, qp1);
          *(LAS unsigned*)(lds + SC_KP + i * 272 + lane * 4) = cvt_pk_bf16(kq0, kq1);
        }
        const int kto = dir ? (56 - 8 * w) * 2 : 16 * w;
        u32x4 t;
        if (dir) { t.x = cvt_pk_bf16(kp0[7], kp0[6]); t.y = cvt_pk_bf16(kp0[5], kp0[4]); t.z = cvt_pk_bf16(kp0[3], kp0[2]); t.w = cvt_pk_bf16(kp0[1], kp0[0]); }
        else { t.x = cvt_pk_bf16(kp0[0], kp0[1]); t.y = cvt_pk_bf16(kp0[2], kp0[3]); t.z = cvt_pk_bf16(kp0[4], kp0[5]); t.w = cvt_pk_bf16(kp0[6], kp0[7]); }
        *(LAS u32x4*)(lds + SC_KT + (2 * lane) * 144 + kto) = t;
        if (dir) { t.x = cvt_pk_bf16(kp1[7], kp1[6]); t.y = cvt_pk_bf16(kp1[5], kp1[4]); t.z = cvt_pk_bf16(kp1[3], kp1[2]); t.w = cvt_pk_bf16(kp1[1], kp1[0]); }
        else { t.x = cvt_pk_bf16(kp1[0], kp1[1]); t.y = cvt_pk_bf16(kp1[2], kp1[3]); t.z = cvt_pk_bf16(kp1[4], kp1[5]); t.w = cvt_pk_bf16(kp1[6], kp1[7]); }
        *(LAS u32x4*)(lds + SC_KT + (2 * lane + 1) * 144 + kto) = t;
        *(LAS u32x4*)(lds + SC_VT + vrow * 144 + vpart * 32) = V0_;
        *(LAS u32x4*)(lds + SC_VT + vrow * 144 + vpart * 32 + 16) = V1_;
      }
      __syncthreads();
      { const int c2_ = (c + 2 < 32) ? cg_ + 2 : cg_; SC_LOAD(c2_, Q_, G_, V0_, V1_); }
      {
#pragma unroll
        for (int g = 0; g < 4; ++g) { const f32x4 eb = *(const LAS f32x4*)(lds + SC_EB + (kbS * 32 + 8 * g + 4 * hh) * 4);
          s0[4 * g] *= eb[0]; s0[4 * g + 1] *= eb[1]; s0[4 * g + 2] *= eb[2]; s0[4 * g + 3] *= eb[3];
          s1[4 * g] *= eb[0]; s1[4 * g + 1] *= eb[1]; s1[4 * g + 2] *= eb[2]; s1[4 * g + 3] *= eb[3]; }
        bf16x8 fk[4], fv0[4], fv1[4];
#pragma unroll
        for (int st = 0; st < 4; ++st) { fk[st] = ldfrag(lds + SC_KT, 144, kbS * 32 + r, 8 * hh + 16 * st); fv0[st] = ldfrag(lds + SC_VT, 144, vbS * 32 + r, 8 * hh + 16 * st); fv1[st] = ldfrag(lds + SC_VT, 144, vbS * 32 + 32 + r, 8 * hh + 16 * st); }
        __builtin_amdgcn_sched_barrier(0);
#pragma unroll
        for (int st = 0; st < 4; ++st) { s0 = MFMA32(fk[st], fv0[st], s0); s1 = MFMA32(fk[st], fv1[st], s1); }
      }
      if (w >= 5) {
        const int jb = (w == 7), ib = (w >= 6);
        f32x16 x;
#pragma unroll
        for (int i = 0; i < 16; ++i) x[i] = 0.f;
        { bf16x8 fa[8], fb[8];
#pragma unroll
          for (int st = 0; st < 8; ++st) { fa[st] = ldfrag(lds + SC_KP, 272, jb * 32 + r, 8 * hh + 16 * st); fb[st] = ldfrag(lds + SC_QP, 272, ib * 32 + r, 8 * hh + 16 * st); }
          __builtin_amdgcn_sched_barrier(0);
#pragma unroll
          for (int st = 0; st < 8; ++st) x = MFMA32(fa[st], fb[st], x); }
        const int ii = ib * 32 + r;
#pragma unroll
        for (int g = 0; g < 4; ++g) {
          const int j0 = jb * 32 + 8 * g + 4 * hh;
          const float x0 = (j0 + 0 <= ii) ? x[4 * g] : 0.f, x1 = (j0 + 1 <= ii) ? x[4 * g + 1] : 0.f, x2 = (j0 + 2 <= ii) ? x[4 * g + 2] : 0.f, x3 = (j0 + 3 <= ii) ? x[4 * g + 3] : 0.f;
          u32x2 pk;
          if (dir) { pk.x = cvt_pk_bf16(x3, x2); pk.y = cvt_pk_bf16(x1, x0); *(LAS u32x2*)(lds + SC_A + ii * 144 + (60 - j0) * 2) = pk; }
          else { pk.x = cvt_pk_bf16(x0, x1); pk.y = cvt_pk_bf16(x2, x3); *(LAS u32x2*)(lds + SC_A + ii * 144 + j0 * 2) = pk; }
        }
      }
      {
#pragma unroll
        for (int i = 0; i < 16; ++i) oacc[i] = 0.f;
        bf16x8 fa[8], fb[8];
#pragma unroll
        for (int st = 0; st < 8; ++st) { fa[st] = ldfrag(lds + SC_QP, 272, ibO * 32 + r, 8 * hh + 16 * st); fb[st] = ldfrag(lds + SC_ST, 272, vbO * 32 + r, 8 * hh + 16 * st); }
        __builtin_amdgcn_sched_barrier(0);
#pragma unroll
        for (int st = 0; st < 8; ++st) oacc = MFMA32(fa[st], fb[st], oacc);
      }
      __syncthreads();
      {
        const int st0 = (ibO == 0 && dir) ? 2 : 0, st1 = (ibO == 0 && !dir) ? 2 : 4;
        { bf16x8 fa[4], fb[4];
#pragma unroll
          for (int st = 0; st < 4; ++st) { fa[st] = ldfrag(lds + SC_A, 144, ibO * 32 + r, 8 * hh + 16 * st); fb[st] = ldfrag(lds + SC_VT, 144, vbO * 32 + r, 8 * hh + 16 * st); }
          __builtin_amdgcn_sched_barrier(0);
#pragma unroll
          for (int st = 0; st < 4; ++st) if (st >= st0 && st < st1) oacc = MFMA32(fa[st], fb[st], oacc); }
        {
          bf16_t* ob0 = ob + (t0 + SC_TOK(cg_, ibO * 32 + 4 * hh)) * HGW + head * HGD + vbO * 32 + r;
          if (dir) {
#pragma unroll
            for (int rg = 0; rg < 16; ++rg) ob0[-((rg & 3) + 8 * (rg >> 2)) * HGW] = __builtin_bit_cast(unsigned short, (__bf16)oacc[rg]);
          } else {
#pragma unroll
            for (int rg = 0; rg < 16; ++rg) ob0[((rg & 3) + 8 * (rg >> 2)) * HGW] = __builtin_bit_cast(unsigned short, (__bf16)oacc[rg]);
          }
        }
#pragma unroll
        for (int g = 0; g < 4; ++g) {
          u32x2 pk; pk.x = cvt_pk_bf16(s0[4 * g], s0[4 * g + 1]); pk.y = cvt_pk_bf16(s0[4 * g + 2], s0[4 * g + 3]);
          *(LAS u32x2*)(lds + SC_ST + (vbS * 32 + r) * 272 + (kbS * 32 + 8 * g + 4 * hh) * 2) = pk;
          pk.x = cvt_pk_bf16(s1[4 * g], s1[4 * g + 1]); pk.y = cvt_pk_bf16(s1[4 * g + 2], s1[4 * g + 3]);
          *(LAS u32x2*)(lds + SC_ST + (vbS * 32 + 32 + r) * 272 + (kbS * 32 + 8 * g + 4 * hh) * 2) = pk;
        }
      }
      __syncthreads();
    };
    for (int c = 0; c < 32; c += 2) { sc_chunk(c, gq, gg, gv0, gv1); sc_chunk(c + 1, gqB, ggB, gv0B, gv1B); }
    {
      float* sl = Sloc + (size_t)(seq * 4 + sg) * 128 * 128;
#pragma unroll
      for (int rg = 0; rg < 16; ++rg) { const int k = kbS * 32 + (rg & 3) + 8 * (rg >> 2) + 4 * hh;
        sl[k * 128 + vbS * 32 + r] = s0[rg]; sl[k * 128 + vbS * 32 + 32 + r] = s1[rg]; }
      if (w == 0) *(f32x2*)(Dtot + (size_t)(seq * 4 + sg) * 128 + 2 * lane) = (f32x2){bsum0, bsum1};
    }
  }
  { PHASE_IDS
    constexpr float LOG2E = 1.4426950408889634f;
    constexpr int NA_TB = 131072;
    const int bh = (bid & 7) * 8 + (bid >> 5), b = bh >> 3, head = bh & 7, rq = (bid >> 3) & 3;
    LAS float* Tb = (LAS float*)(lds + NA_TB);
    for (int idx = tid; idx < 15 * 128; idx += NT) { const int dr = idx >> 7, xx = (idx & 127) - 48; Tb[idx] = (xx >= 0 && xx <= 30) ? rpb[(head * 15 + dr) * 31 + xx] * LOG2E : 0.f; }
    const int w = __builtin_amdgcn_readfirstlane(wid), qb = w & 1, hh = lane >> 5, ql = lane & 31, c = 32 * qb + ql;
    int cs = c - KW / 2; cs = cs < 0 ? 0 : (cs > GW - KW ? GW - KW : cs);
    float cm[3][2][4];
#pragma unroll
    for (int cbi = 0; cbi < 3; ++cbi)
#pragma unroll
      for (int g1 = 0; g1 < 2; ++g1)
#pragma unroll
        for (int jj = 0; jj < 4; ++jj) { const int kc = 16 * (qb + cbi) + 8 * hh + 4 * g1 + jj; cm[cbi][g1][jj] = (kc >= cs && kc < cs + KW) ? 0.f : -1.0e30f; }
    const int lbase = NA_TB + ((63 - c) + 8 * hh + 16 * qb) * 4;
    const int colperm = 8 * ((ql >> 2) & 1) + 4 * ((ql >> 3) & 1) + (ql & 3);
    const int koff = (hh * 64 + 16 * qb + colperm) * 16;
    const int voff = 8192 + ((2 * qb + hh) * 64 + ql) * 16;
    const bf16_t* Krows = NAK + (size_t)((b * 8 + head) * 128) * 4096 + tid * 8;
    const bf16_t* Vrows = NAV + (size_t)((b * 8 + head) * 128) * 4096 + tid * 8;
#define NA_RS(r_) ((r_) - KH / 2 < 0 ? 0 : ((r_) - KH / 2 > ROWS - KH ? ROWS - KH : (r_) - KH / 2))
    bf16x8 Qn[4];
#define NA_QLD(u_) do { const size_t tq_ = (size_t)b * SEQ + (32 * rq + 4 * (u_) + (w >> 1)) * GW + c; \
      _Pragma("unroll") for (int st = 0; st < 4; ++st) Qn[st] = *(const bf16x8*)(NAQ + tq_ * NAW + head * NADH + 16 * st + 8 * hh); } while (0)
    NA_QLD(0);
    {
      const int rlo = NA_RS(32 * rq), rhi = NA_RS(32 * rq + 31) + 7;
      unsigned acc_t = 0u;
      for (int i = tid; i < (rhi - rlo + 1) * 2; i += NT) {
        acc_t += *(const unsigned*)(NAK + (size_t)((b * 8 + head) * 128 + rlo) * 4096 + (size_t)i * 2048);
        acc_t += *(const unsigned*)(NAV + (size_t)((b * 8 + head) * 128 + rlo) * 4096 + (size_t)i * 2048);
      }
      for (int i = tid; i < 32 * 64 / 4; i += NT) {
        const size_t tk = (size_t)b * SEQ + (32 * rq) * GW + 4 * i;
        acc_t += *(const unsigned*)(NAQ + tk * NAW + head * NADH);
        acc_t += *(const unsigned*)(a_na + tk * NAW + head * NADH);
      }
      asm volatile("" :: "v"(acc_t));
    }
    int hi;
    {
      const int r0 = 32 * rq; const int lo = NA_RS(r0); hi = NA_RS(r0 + 3) + 1;
      u32x4 kv[5], vv[5];
#pragma unroll
      for (int k = 0; k < 5; ++k) { const int row = (lo + k <= hi) ? lo + k : hi; kv[k] = *(const u32x4*)(Krows + (size_t)row * 4096); vv[k] = *(const u32x4*)(Vrows + (size_t)row * 4096); }
#pragma unroll
      for (int k = 0; k < 5; ++k) { const int row = (lo + k <= hi) ? lo + k : hi;
        *(LAS u32x4*)(lds + (row & 7) * 16384 + tid * 16) = kv[k]; *(LAS u32x4*)(lds + (row & 7) * 16384 + 8192 + tid * 16) = vv[k]; }
    }
#define NA_NEED(k_) ((k_) >= 32 ? ROWS - 1 : (NA_RS(32 * rq + 4 * ((k_) >> 2) + 3) + 2 * ((k_) & 3) + 1 > ROWS - 1 ? ROWS - 1 : NA_RS(32 * rq + 4 * ((k_) >> 2) + 3) + 2 * ((k_) & 3) + 1))
    u32x4 pkO0, pvO0, pkO1, pvO1; int nO;
    { int t1 = NA_NEED(1); t1 = t1 < hi ? hi : t1; nO = t1 - hi;
      if (nO >= 1) { pkO0 = *(const u32x4*)(Krows + (size_t)(hi + 1) * 4096); pvO0 = *(const u32x4*)(Vrows + (size_t)(hi + 1) * 4096); }
      if (nO >= 2) { pkO1 = *(const u32x4*)(Krows + (size_t)(hi + 2) * 4096); pvO1 = *(const u32x4*)(Vrows + (size_t)(hi + 2) * 4096); } }
#pragma unroll 1
    for (int u = 0; u < 8; ++u) {
      const int r0u = 32 * rq + 4 * u, r = r0u + (w >> 1);
      const int rs = NA_RS(r), dr0 = rs - r + 7;
      const size_t tokQ = (size_t)b * SEQ + r * GW + c;
      bf16x8 Qf[4];
#pragma unroll
      for (int st = 0; st < 4; ++st) Qf[st] = Qn[st];
      asm volatile("" : "+v"(Qf[0]), "+v"(Qf[1]), "+v"(Qf[2]), "+v"(Qf[3]));
      NA_QLD(u < 7 ? u + 1 : u);
      float mx = -1.0e30f, lsum = 0.f; f32x16 o0, o1;
#pragma unroll
      for (int i = 0; i < 16; ++i) { o0[i] = 0.f; o1[i] = 0.f; }
#pragma unroll 1
      for (int i2 = 0; i2 < 4; ++i2) {
        __syncthreads();
        const int kstep_ = 4 * u + i2, req = hi + nO;
        int tgt = (kstep_ + 2 < 32) ? NA_NEED(kstep_ + 2) : req; tgt = tgt < req ? req : tgt;
        const int nN = tgt - req;
        u32x4 pkN0, pvN0, pkN1, pvN1;
        if (nN >= 1) { pkN0 = *(const u32x4*)(Krows + (size_t)(req + 1) * 4096); pvN0 = *(const u32x4*)(Vrows + (size_t)(req + 1) * 4096); }
        if (nN >= 2) { pkN1 = *(const u32x4*)(Krows + (size_t)(req + 2) * 4096); pvN1 = *(const u32x4*)(Vrows + (size_t)(req + 2) * 4096); }
        const int tbo = lbase + (dr0 + 2 * i2) * 512;
        const int kslot = ((rs + 2 * i2 + (ql >> 4)) & 7) * 16384 + koff;
        const int vslot0 = ((rs + 2 * i2) & 7) * 16384 + voff, vslot1 = ((rs + 2 * i2 + 1) & 7) * 16384 + voff;
#pragma unroll
        for (int cbi = 0; cbi < 3; ++cbi) {
          f32x16 acc;
#pragma unroll
          for (int rg = 0; rg < 16; ++rg) { const int gg = rg >> 2, jj = rg & 3;
            acc[rg] = *(const LAS float*)(lds + tbo + (gg >> 1) * 512 + (16 * cbi + 4 * (gg & 1) + jj) * 4) + cm[cbi][gg & 1][jj]; }
          {
            bf16x8 kf[4];
#pragma unroll
            for (int st = 0; st < 4; ++st) kf[st] = *(const LAS bf16x8*)(lds + kslot + (2 * st * 64 + 16 * cbi) * 16);
            __builtin_amdgcn_sched_barrier(0);
#pragma unroll
            for (int st = 0; st < 4; ++st) acc = MFMA32(kf[st], Qf[st], acc);
          }
          bf16x8 vf[4];
          vf[0] = *(const LAS bf16x8*)(lds + vslot0 + (2 * cbi * 64) * 16); vf[1] = *(const LAS bf16x8*)(lds + vslot0 + (2 * cbi * 64 + 32) * 16);
          vf[2] = *(const LAS bf16x8*)(lds + vslot1 + (2 * cbi * 64) * 16); vf[3] = *(const LAS bf16x8*)(lds + vslot1 + (2 * cbi * 64 + 32) * 16);
          float tm = fmaxf(fmaxf(fmaxf(acc[0], acc[1]), fmaxf(acc[2], acc[3])), fmaxf(fmaxf(acc[4], acc[5]), fmaxf(acc[6], acc[7])));
          tm = fmaxf(tm, fmaxf(fmaxf(fmaxf(acc[8], acc[9]), fmaxf(acc[10], acc[11])), fmaxf(fmaxf(acc[12], acc[13]), fmaxf(acc[14], acc[15]))));
          tm = half_swap_max(tm);
          const float mn = fmaxf(mx, tm), alpha = __builtin_amdgcn_exp2f(mx - mn);
          mx = mn;
          bf16x8 Pf[2]; float ts = 0.f;
#pragma unroll
          for (int st = 0; st < 2; ++st) {
            float pv[8];
#pragma unroll
            for (int j = 0; j < 8; ++j) { pv[j] = __builtin_amdgcn_exp2f(acc[8 * st + j] - mn); ts += pv[j]; }
            u32x4 pk; pk.x = cvt_pk_bf16(pv[0], pv[1]); pk.y = cvt_pk_bf16(pv[2], pv[3]); pk.z = cvt_pk_bf16(pv[4], pv[5]); pk.w = cvt_pk_bf16(pv[6], pv[7]);
            Pf[st] = __builtin_bit_cast(bf16x8, pk);
          }
          lsum = lsum * alpha + ts;
#pragma unroll
          for (int i = 0; i < 16; ++i) { o0[i] *= alpha; o1[i] *= alpha; }
          o0 = MFMA32(vf[0], Pf[0], o0);
          o1 = MFMA32(vf[1], Pf[0], o1);
          o0 = MFMA32(vf[2], Pf[1], o0);
          o1 = MFMA32(vf[3], Pf[1], o1);
        }
        if (nO >= 1) { *(LAS u32x4*)(lds + ((hi + 1) & 7) * 16384 + tid * 16) = pkO0; *(LAS u32x4*)(lds + ((hi + 1) & 7) * 16384 + 8192 + tid * 16) = pvO0; }
        if (nO >= 2) { *(LAS u32x4*)(lds + ((hi + 2) & 7) * 16384 + tid * 16) = pkO1; *(LAS u32x4*)(lds + ((hi + 2) & 7) * 16384 + 8192 + tid * 16) = pvO1; }
        hi = req; nO = nN; pkO0 = pkN0; pvO0 = pvN0; pkO1 = pkN1; pvO1 = pvN1;
      }
      lsum = half_swap_sum(lsum);
      const float inv = 1.f / lsum;
      bf16_t* op = a_na + tokQ * NAW + head * NADH + 4 * hh;
#pragma unroll
      for (int g = 0; g < 4; ++g) {
        u32x2 pk; pk.x = cvt_pk_bf16(o0[4 * g] * inv, o0[4 * g + 1] * inv); pk.y = cvt_pk_bf16(o0[4 * g + 2] * inv, o0[4 * g + 3] * inv);
        *(u32x2*)(op + 8 * g) = pk;
        pk.x = cvt_pk_bf16(o1[4 * g] * inv, o1[4 * g + 1] * inv); pk.y = cvt_pk_bf16(o1[4 * g + 2] * inv, o1[4 * g + 3] * inv);
        *(u32x2*)(op + 32 + 8 * g) = pk;
      }
    }
  }
#undef NA_NEED
#undef NA_RS
#undef NA_QLD
  GRID_BAR();
  { PHASE_IDS
    const int w = __builtin_amdgcn_readfirstlane(wid);
    const int seq = bid >> 2, sg = bid & 3, b = seq >> 3, dir = (seq >> 2) & 1, head = seq & 3;
    if (sg > 0) {
      const bf16_t* Gp = dir ? GBW : GF; bf16_t* ob = dir ? obb : obf;
      const size_t t0 = (size_t)b * SEQ;
      const int hh = lane >> 5, r = lane & 31;
      constexpr float LOG2E = 1.4426950408889634f;
      const int kbS = w >> 1, vbS = 2 * (w & 1), ibO = w >> 2, vbO = w & 3;
      {
        f32x16 s0, s1;
#pragma unroll
        for (int i = 0; i < 16; ++i) { s0[i] = 0.f; s1[i] = 0.f; }
        for (int q = 0; q < sg; ++q) {
          const float* sl = Sloc + (size_t)(seq * 4 + q) * 128 * 128; const float* dt = Dtot + (size_t)(seq * 4 + q) * 128;
#pragma unroll
          for (int rg = 0; rg < 16; ++rg) { const int k = kbS * 32 + (rg & 3) + 8 * (rg >> 2) + 4 * hh; const float dk = __builtin_amdgcn_exp2f(dt[k]);
            s0[rg] = s0[rg] * dk + sl[k * 128 + vbS * 32 + r]; s1[rg] = s1[rg] * dk + sl[k * 128 + vbS * 32 + 32 + r]; }
        }
#pragma unroll
        for (int g = 0; g < 4; ++g) {
          u32x2 pk; pk.x = cvt_pk_bf16(s0[4 * g], s0[4 * g + 1]); pk.y = cvt_pk_bf16(s0[4 * g + 2], s0[4 * g + 3]);
          *(LAS u32x2*)(lds + SC_ST + (vbS * 32 + r) * 272 + (kbS * 32 + 8 * g + 4 * hh) * 2) = pk;
          pk.x = cvt_pk_bf16(s1[4 * g], s1[4 * g + 1]); pk.y = cvt_pk_bf16(s1[4 * g + 2], s1[4 * g + 3]);
          *(LAS u32x2*)(lds + SC_ST + (vbS * 32 + 32 + r) * 272 + (kbS * 32 + 8 * g + 4 * hh) * 2) = pk;
        }
      }
      const int coff = head * HGD + 2 * lane;
      float bp0 = 0.f, bp1 = 0.f;
      unsigned gq[8], gg[8], gqn[8], ggn[8];
#define P2S_LOAD(c_, Q_, G_) do { _Pragma("unroll") for (int e = 0; e < 8; ++e) { const size_t tk = t0 + SC_TOK(32 * sg + (c_), 8 * w + e); Q_[e] = *(const unsigned*)(HQ + tk * HGW + coff); G_[e] = *(const unsigned*)(Gp + tk * HGW + coff); } } while (0)
      P2S_LOAD(0, gq, gg);
      for (int c = 0; c < 32; ++c) {
        if (!__any(bp0 > -160.f || bp1 > -160.f)) break;
        const int cg_ = 32 * sg + c;
        P2S_LOAD(c + 1 < 32 ? c + 1 : c, gqn, ggn);
        float c0[8], c1[8];
        { float a0 = 0.f, a1 = 0.f;
#pragma unroll
          for (int e = 0; e < 8; ++e) { a0 += h2f((unsigned short)(gg[e] & 0xffffu)) * LOG2E; a1 += h2f((unsigned short)(gg[e] >> 16)) * LOG2E; c0[e] = a0; c1[e] = a1; }
          *(LAS f32x2*)(lds + SC_TOT + (w * 128 + 2 * lane) * 4) = (f32x2){a0, a1}; }
        __syncthreads();
        float off0 = bp0, off1 = bp1, bl0 = 0.f, bl1 = 0.f;
#pragma unroll
        for (int w2 = 0; w2 < 8; ++w2) { const f32x2 tv = *(const LAS f32x2*)(lds + SC_TOT + (w2 * 128 + 2 * lane) * 4);
          bl0 += tv.x; bl1 += tv.y; if (w2 < w) { off0 += tv.x; off1 += tv.y; } }
        bp0 += bl0; bp1 += bl1;
#pragma unroll
        for (int e = 0; e < 8; ++e) {
          const float q0 = __uint_as_float(gq[e] << 16), q1 = __uint_as_float(gq[e] & 0xffff0000u);
          *(LAS unsigned*)(lds + SC_QP + (8 * w + e) * 272 + lane * 4) = cvt_pk_bf16(q0 * __builtin_amdgcn_exp2f(off0 + c0[e]), q1 * __builtin_amdgcn_exp2f(off1 + c1[e]));
        }
        __syncthreads();
        f32x16 oacc;
#pragma unroll
        for (int i = 0; i < 16; ++i) oacc[i] = 0.f;
        { bf16x8 fa[8], fb[8];
#pragma unroll
          for (int st = 0; st < 8; ++st) { fa[st] = ldfrag(lds + SC_QP, 272, ibO * 32 + r, 8 * hh + 16 * st); fb[st] = ldfrag(lds + SC_ST, 272, vbO * 32 + r, 8 * hh + 16 * st); }
          __builtin_amdgcn_sched_barrier(0);
#pragma unroll
          for (int st = 0; st < 8; ++st) oacc = MFMA32(fa[st], fb[st], oacc); }
        {
          unsigned short ov[16];
#pragma unroll
          for (int rg = 0; rg < 16; ++rg) { const int i = ibO * 32 + (rg & 3) + 8 * (rg >> 2) + 4 * hh; ov[rg] = ob[(t0 + SC_TOK(cg_, i)) * HGW + head * HGD + vbO * 32 + r]; }
          asm volatile("" : "+v"(ov[0]), "+v"(ov[1]), "+v"(ov[2]), "+v"(ov[3]), "+v"(ov[4]), "+v"(ov[5]), "+v"(ov[6]), "+v"(ov[7]));
          asm volatile("" : "+v"(ov[8]), "+v"(ov[9]), "+v"(ov[10]), "+v"(ov[11]), "+v"(ov[12]), "+v"(ov[13]), "+v"(ov[14]), "+v"(ov[15]));
#pragma unroll
          for (int rg = 0; rg < 16; ++rg) { const int i = ibO * 32 + (rg & 3) + 8 * (rg >> 2) + 4 * hh;
            ob[(t0 + SC_TOK(cg_, i)) * HGW + head * HGD + vbO * 32 + r] = __builtin_bit_cast(unsigned short, (__bf16)(bf2f(ov[rg]) + oacc[rg])); }
        }
        __syncthreads();
#pragma unroll
        for (int e = 0; e < 8; ++e) { gq[e] = gqn[e]; gg[e] = ggn[e]; }
      }
#undef P2S_LOAD
    }
  }
#undef SC_TOK
#undef SC_LOAD
  GRID_BAR();
  { PHASE_IDS
    f32x4 ng0 = *(const f32x4*)(hg_ng + lane * 8), ng1 = *(const f32x4*)(hg_ng + lane * 8 + 4);
    u32x4 fan[2], fbn[2], ggn[2];
#define P2B_LOAD(t_) do { _Pragma("unroll") for (int q = 0; q < 2; ++q) { const size_t o0 = (size_t)((t_) + q) * HGW + lane * 8; \
      fan[q] = *(const u32x4*)(obf + o0); fbn[q] = *(const u32x4*)(obb + o0); ggn[q] = *(const u32x4*)(HG + o0); } } while (0)
    P2B_LOAD(2 * gw);
#pragma unroll 1
    for (int t = 2 * gw; t < NTOK; t += 2 * NGW) {
      u32x4 fa[2], fb[2], gg2[2];
#pragma unroll
      for (int q = 0; q < 2; ++q) { fa[q] = fan[q]; fb[q] = fbn[q]; gg2[q] = ggn[q]; }
      if (t + 2 * NGW < NTOK) P2B_LOAD(t + 2 * NGW);
#pragma unroll
      for (int q = 0; q < 2; ++q) {
        float a[8]; float ss = 0.f;
#pragma unroll
        for (int e = 0; e < 4; ++e) {
          a[2 * e] = __uint_as_float(fa[q][e] << 16) + __uint_as_float(fb[q][e] << 16);
          a[2 * e + 1] = __uint_as_float(fa[q][e] & 0xffff0000u) + __uint_as_float(fb[q][e] & 0xffff0000u);
          ss += a[2 * e] * a[2 * e] + a[2 * e + 1] * a[2 * e + 1];
        }
        ss = row_sum16(ss);
        const float rs = rsqrtf(ss * (1.f / HGD) + RMS_EPS);
        const float ngv[8] = {ng0.x, ng0.y, ng0.z, ng0.w, ng1.x, ng1.y, ng1.z, ng1.w};
        float o[8];
#pragma unroll
        for (int e = 0; e < 4; ++e) {
          o[2 * e] = a[2 * e] * rs * ngv[2 * e] * __uint_as_float(gg2[q][e] << 16);
          o[2 * e + 1] = a[2 * e + 1] * rs * ngv[2 * e + 1] * __uint_as_float(gg2[q][e] & 0xffff0000u);
        }
        u32x4 w; w.x = cvt_pk_bf16(o[0], o[1]); w.y = cvt_pk_bf16(o[2], o[3]); w.z = cvt_pk_bf16(o[4], o[5]); w.w = cvt_pk_bf16(o[6], o[7]);
        *(u32x4*)(c_hg + (size_t)(t + q) * HGW + lane * 8) = w;
      }
    }
#undef P2B_LOAD
  }
  GRID_BAR();
  {
    pg8::Gemm g{c_hg, WT_pb, HGW, 0, a_na, WT_pa, HGW / 64}; pg8::StaticOrder S; S.init(NTOK, D, G, bid);
    pg8::EpiGate<0> E{GA, GBT, merged};
    pg8::gemm_phase<pg8::EpiGate<0>, pg8::StaticOrder, true>(lds, g, S, E, (HGW + NAW) / 64);
  }
  GRID_BAR();
  {
    pg8::Gemm g{merged, WT_out, D, 0}; pg8::StaticOrder S; S.init(NTOK, D, G, bid);
    pg8::EpiBf16 E{T1, D};
    pg8::gemm_phase(lds, g, S, E);
  }
  GRID_BAR();
  { PHASE_IDS
    for (int i = bid * NT + tid; i < MAXROWS; i += G * NT) srt[i] = 0;
    LAS f32x4* WE = (LAS f32x4*)lds; LAS f32x4* WG = (LAS f32x4*)(lds + 131072); LAS u32x2* PRM = (LAS u32x2*)(lds + 147456);
    LAS int* lcnt = (LAS int*)(lds + 155648); LAS float* rbias = (LAS float*)(lds + 155648 + 128);
    {
      f32x4 tw[16], tg2[2];
#pragma unroll
      for (int k = 0; k < 16; ++k) { const int idx = tid + k * NT; tw[k] = *(const f32x4*)(w_re + (size_t)(idx >> 3) * NE + 4 * (idx & 7)); }
#pragma unroll
      for (int k = 0; k < 2; ++k) tg2[k] = *(const f32x4*)(w_rg + (size_t)(tid + k * NT) * NG);
#pragma unroll
      for (int k = 0; k < 16; ++k) { const int idx = tid + k * NT; const int row = idx >> 3, q = idx & 7, jj = row >> 6, l = (row >> 2) & 15, e = row & 3; WE[((jj * 4 + e) * 8 + q) * 16 + l] = tw[k]; }
#pragma unroll
      for (int k = 0; k < 2; ++k) { const int row = tid + k * NT; const int jj = row >> 6, l = (row >> 2) & 15, e = row & 3; WG[(jj * 4 + e) * 16 + l] = tg2[k]; }
    }
    for (int idx = tid; idx < 1024; idx += NT) { const int which = idx >> 8, c4 = idx & 255;
      const float* src = which == 0 ? emb_g : (which == 1 ? emb_b : (which == 2 ? ln1_g : ln1_b)); f32x4 pv = *(const f32x4*)(src + 4 * c4); if (which == 1) pv = pv * ALPHA;
      u32x2 pk; pk.x = pk2h(pv.x, pv.y); pk.y = pk2h(pv.z, pv.w); PRM[(which * 16 + (c4 >> 4)) * 16 + (c4 & 15)] = pk; }
    if (tid < NE) { lcnt[tid] = 0; rbias[4 + tid] = b_re[tid]; } if (tid < NG) rbias[tid] = b_rg[tid];
    __syncthreads();
    const int l16 = lane & 15, tg = lane >> 4;
    constexpr float LOG2E = 1.4426950408889634f;
#define P3D_H4(w_) (f32x4){h2f((unsigned short)((w_).x & 0xffffu)), h2f((unsigned short)((w_).x >> 16)), h2f((unsigned short)((w_).y & 0xffffu)), h2f((unsigned short)((w_).y >> 16))}
    u32x2 xn[16], mn[16];
#define P3D_LOAD(t_) do { const u32x2* xr_ = (const u32x2*)(hb + (size_t)(t_) * D) + l16; const u32x2* mr_ = (const u32x2*)(T1 + (size_t)(t_) * D) + l16; \
      _Pragma("unroll") for (int jj = 0; jj < 16; ++jj) { xn[jj] = xr_[16 * jj]; mn[jj] = mr_[16 * jj]; } } while (0)
    P3D_LOAD(bid * 256 + wid * 32 + tg);
#pragma unroll 1
    for (int it = 0; it < 8; ++it) {
      const int t = bid * 256 + wid * 32 + 4 * it + tg;
      f32x4 v[16]; float s = 0.f;
      {
        u32x2 hv[16], mv[16];
#pragma unroll
        for (int jj = 0; jj < 16; ++jj) { hv[jj] = xn[jj]; mv[jj] = mn[jj]; }
        if (it < 7) P3D_LOAD(t + 4);
#pragma unroll
        for (int jj = 0; jj < 16; ++jj) {
          const f32x4 hx4 = (f32x4){__uint_as_float(hv[jj].x << 16), __uint_as_float(hv[jj].x & 0xffff0000u), __uint_as_float(hv[jj].y << 16), __uint_as_float(hv[jj].y & 0xffff0000u)};
          const f32x4 mx4 = (f32x4){__uint_as_float(mv[jj].x << 16), __uint_as_float(mv[jj].x & 0xffff0000u), __uint_as_float(mv[jj].y << 16), __uint_as_float(mv[jj].y & 0xffff0000u)};
          v[jj] = hx4 * ALPHA + mx4;
          s += (v[jj].x + v[jj].y) + (v[jj].z + v[jj].w);
        }
      }
      const float mean = row_sum16(s) * (1.f / D); float s2 = 0.f;
#pragma unroll
      for (int jj = 0; jj < 16; ++jj) { v[jj] = v[jj] - mean; s2 += (v[jj].x * v[jj].x + v[jj].y * v[jj].y) + (v[jj].z * v[jj].z + v[jj].w * v[jj].w); }
      const float rstd = rsqrtf(row_sum16(s2) * (1.f / D) + LN_EPS);
      float gl[NG];
#pragma unroll
      for (int i = 0; i < NG; ++i) gl[i] = 0.f;
      u32x2* o8 = (u32x2*)(h1b + (size_t)t * D) + l16;
#pragma unroll
      for (int jj = 0; jj < 16; ++jj) {
        const f32x4 lg = P3D_H4(PRM[(2 * 16 + jj) * 16 + l16]), lb_ = P3D_H4(PRM[(3 * 16 + jj) * 16 + l16]);
        const f32x4 o = v[jj] * rstd * lg + lb_;
        v[jj] = o;
        u32x2 w; w.x = cvt_pk_bf16(o.x, o.y); w.y = cvt_pk_bf16(o.z, o.w); o8[16 * jj] = w;
#pragma unroll
        for (int e = 0; e < 4; ++e) {
          const f32x4 wg = WG[(jj * 4 + e) * 16 + l16];
          gl[0] = fmaf(o[e], wg.x, gl[0]); gl[1] = fmaf(o[e], wg.y, gl[1]); gl[2] = fmaf(o[e], wg.z, gl[2]); gl[3] = fmaf(o[e], wg.w, gl[3]);
        }
      }
#pragma unroll
      for (int i = 0; i < NG; ++i) gl[i] = row_sum16(gl[i]) + rbias[i];
      int gs = 0; float gm = gl[0];
#pragma unroll
      for (int i = 1; i < NG; ++i) if (gl[i] > gm) { gm = gl[i]; gs = i; }
      float gden = 0.f;
#pragma unroll
      for (int i = 0; i < NG; ++i) gden += __builtin_amdgcn_exp2f((gl[i] - gm) * LOG2E);
      const float gwt = 1.f / gden;
      float ev[EPG];
#pragma unroll
      for (int i = 0; i < EPG; ++i) ev[i] = 0.f;
      const LAS f32x4* wes = WE + (2 * gs) * 16 + l16;
#pragma unroll
      for (int jj = 0; jj < 16; ++jj) {
#pragma unroll
        for (int e = 0; e < 4; ++e) {
          const f32x4 wa = wes[(jj * 4 + e) * 8 * 16], wb = wes[(jj * 4 + e) * 8 * 16 + 16]; const float ov = v[jj][e];
          ev[0] = fmaf(ov, wa.x, ev[0]); ev[1] = fmaf(ov, wa.y, ev[1]); ev[2] = fmaf(ov, wa.z, ev[2]); ev[3] = fmaf(ov, wa.w, ev[3]);
          ev[4] = fmaf(ov, wb.x, ev[4]); ev[5] = fmaf(ov, wb.y, ev[5]); ev[6] = fmaf(ov, wb.z, ev[6]); ev[7] = fmaf(ov, wb.w, ev[7]);
        }
      }
#pragma unroll
      for (int i = 0; i < EPG; ++i) ev[i] = row_sum16(ev[i]) + rbias[4 + gs * EPG + i];
      int i0 = 0; float m0 = ev[0];
#pragma unroll
      for (int i = 1; i < EPG; ++i) if (ev[i] > m0) { m0 = ev[i]; i0 = i; }
      int i1 = -1; float m1v = -3.0e38f;
#pragma unroll
      for (int i = 0; i < EPG; ++i) if (i != i0 && ev[i] > m1v) { m1v = ev[i]; i1 = i; }
      const float p1 = __builtin_amdgcn_exp2f((m1v - m0) * LOG2E);
      if (l16 == 0) {
        const int e0 = gs * EPG + i0, e1 = gs * EPG + i1;
        tok_w[2 * t] = gwt / (1.f + p1); tok_w[2 * t + 1] = gwt * p1 / (1.f + p1);
        tok_e[2 * t] = e0; tok_e[2 * t + 1] = e1;
        tok_p[2 * t] = __hip_atomic_fetch_add(lcnt + e0, 1, __ATOMIC_RELAXED, __HIP_MEMORY_SCOPE_WORKGROUP);
        tok_p[2 * t + 1] = __hip_atomic_fetch_add(lcnt + e1, 1, __ATOMIC_RELAXED, __HIP_MEMORY_SCOPE_WORKGROUP);
      }
    }
#undef P3D_H4
#undef P3D_LOAD
    __syncthreads();
    if (tid < NE) blk_base[bid * NE + tid] = atomicAdd(&cnt[tid], lcnt[tid]);
    __syncthreads();
  }
  GRID_BAR();
  { PHASE_IDS
    LAS int* loff = (LAS int*)lds;
    if (tid < 64) {
      const int e = lane; const int c_e = (e < NE) ? cnt[e] : 0; const int nt_e = (c_e + 255) >> 8;
      int incl = nt_e;
#pragma unroll
      for (int d = 1; d < 32; d <<= 1) { const int v = __shfl_up(incl, d); if (lane >= d) incl += v; }
      const int start = (incl - nt_e) << 8;
      if (e < NE) loff[e] = start;
      if (e == NE - 1) loff[NE] = incl << 8;
      if (bid == 0) {
        if (e < NE) { for (int q = 0; q < nt_e; ++q) tile_e[(start >> 8) + q] = e; offs[e] = start; }
        if (e == NE - 1) { *nmt_p = incl; offs[NE] = incl << 8; }
      }
    }
    __syncthreads();
    for (int it = bid * NT + tid; it < NTOK * 2; it += G * NT) {
      const int t = it >> 1; const int ee = tok_e[it];
      const int row = loff[ee] + blk_base[(t >> 8) * NE + ee] + tok_p[it];
      srt[row] = t; tok_p[it] = row;
    }
    __syncthreads();
  }
  GRID_BAR();
  {
    const int nmt = *nmt_p;
    {
      LAS int* le = (LAS int*)(lds + pg8::GEMM_LE_OFF);
      if (threadIdx.x < 16) { const int pm = (int)threadIdx.x * (G >> 2) + ((bid >> 3) >> 2) * 8 + (bid & 7); le[threadIdx.x] = pm < nmt ? tile_e[pm] : 0; }
      __syncthreads();
    }
    pg8::Gemm g{h1b, WT_gu, D, (size_t)1024 * D * 2, nullptr, nullptr, 0, srt}; pg8::GroupedOrder S{(const LAS int*)(lds + pg8::GEMM_LE_OFF), nmt, G, bid};
    pg8::EpiSwiGLU E{hid};
    pg8::gemm_phase<pg8::EpiSwiGLU, pg8::GroupedOrder, false, true>(lds, g, S, E);
  }
  GRID_BAR();
  {
    pg8::Gemm g{hid, WT_d, DFF, (size_t)1024 * DFF * 2}; pg8::GroupedOrder S{(const LAS int*)(lds + pg8::GEMM_LE_OFF), *nmt_p, G, bid};
    pg8::EpiBf16 E{ybuf, D};
    pg8::gemm_phase(lds, g, S, E);
  }
  GRID_BAR();
  { PHASE_IDS
    f32x4 gq4[4], bq4[4];
#pragma unroll
    for (int j = 0; j < 4; ++j) { gq4[j] = ((const f32x4*)ln2_g)[lane + 64 * j]; bq4[j] = ((const f32x4*)ln2_b)[lane + 64 * j]; }
    u32x2 hbv[4], yav[4], ycv[4];
    int rA = 0, rB = 0; float wA = 0.f, wB = 0.f;
#define P5_IDX(t_) do { rA = tok_p[2 * (t_)]; rB = tok_p[2 * (t_) + 1]; wA = tok_w[2 * (t_)]; wB = tok_w[2 * (t_) + 1]; } while (0)
#define P5_LOAD(t_) do { \
      const u32x2* hb_ = (const u32x2*)(h1b + (size_t)(t_) * D) + lane; const u32x2* ya_ = (const u32x2*)(ybuf + (size_t)rA * D) + lane; const u32x2* yc_ = (const u32x2*)(ybuf + (size_t)rB * D) + lane; \
      _Pragma("unroll") for (int j = 0; j < 4; ++j) { hbv[j] = hb_[64 * j]; yav[j] = ya_[64 * j]; ycv[j] = yc_[64 * j]; } } while (0)
    float w0n = 0.f, w1n = 0.f;
    if (gw < NTOK) { P5_IDX(gw); P5_LOAD(gw); w0n = wA; w1n = wB; if (gw + NGW < NTOK) P5_IDX(gw + NGW); }
    for (int t = gw; t < NTOK; t += NGW) {
      f32x4 v[4]; float s = 0.f; const float w0 = w0n, w1 = w1n;
#pragma unroll
      for (int j = 0; j < 4; ++j) {
        const u32x2 hb2 = hbv[j], a = yav[j], c = ycv[j];
        const f32x4 hv = (f32x4){__uint_as_float(hb2.x << 16), __uint_as_float(hb2.x & 0xffff0000u), __uint_as_float(hb2.y << 16), __uint_as_float(hb2.y & 0xffff0000u)};
        const f32x4 ya = (f32x4){__uint_as_float(a.x << 16), __uint_as_float(a.x & 0xffff0000u), __uint_as_float(a.y << 16), __uint_as_float(a.y & 0xffff0000u)};
        const f32x4 yc = (f32x4){__uint_as_float(c.x << 16), __uint_as_float(c.x & 0xffff0000u), __uint_as_float(c.y << 16), __uint_as_float(c.y & 0xffff0000u)};
        v[j] = hv * ALPHA + (ya * w0 + yc * w1);
        s += (v[j].x + v[j].y) + (v[j].z + v[j].w);
      }
      if (t + NGW < NTOK) { P5_LOAD(t + NGW); w0n = wA; w1n = wB; if (t + 2 * NGW < NTOK) P5_IDX(t + 2 * NGW); }
      const float mean = wave_sum(s) * (1.f / D); float s2 = 0.f;
#pragma unroll
      for (int j = 0; j < 4; ++j) { v[j] = v[j] - mean; s2 += (v[j].x * v[j].x + v[j].y * v[j].y) + (v[j].z * v[j].z + v[j].w * v[j].w); }
      const float rstd = rsqrtf(wave_sum(s2) * (1.f / D) + LN_EPS);
      f32x4* hr = (f32x4*)(h1 + (size_t)t * D) + lane;
#pragma unroll
      for (int j = 0; j < 4; ++j) hr[64 * j] = v[j] * rstd * gq4[j] + bq4[j];
    }
#undef P5_IDX
#undef P5_LOAD
  }
}

extern "C" void kernel_launch(void* const* d_in, const int* in_sizes, int n_in, void* d_out, int out_size,
                              void* d_ws, size_t ws_size, hipStream_t stream) {
  constexpr size_t kDynLds = LDS_BYTES;
  static int grid_blocks = 0;
  if (!grid_blocks) {
    int dev = 0, cus = 0, per_cu = 0;
    (void)hipGetDevice(&dev);
    (void)hipDeviceGetAttribute(&cus, hipDeviceAttributeMultiprocessorCount, dev);
    (void)hipFuncSetAttribute((const void*)fwd_megakernel, hipFuncAttributeMaxDynamicSharedMemorySize, (int)kDynLds);
    (void)hipOccupancyMaxActiveBlocksPerMultiprocessor(&per_cu, fwd_megakernel, NT, kDynLds);
    if (per_cu < 1) fprintf(stderr, "occupancy query says %d blocks per CU\n", per_cu);
    grid_blocks = 256;
    if (cus < 256) fprintf(stderr, "device has %d CUs; this kernel needs 256 resident workgroups\n", cus);
    if (ws_size < WS_END) fprintf(stderr, "workspace too small: %zu < %zu\n", ws_size, (size_t)WS_END);
  }
  Params p{};
  for (int i = 0; i < 21; ++i) p.in[i] = (const float*)d_in[i];
  p.out = (float*)d_out; p.ws = (unsigned char*)d_ws;
  void* args[] = {&p};
  hipError_t e = hipLaunchCooperativeKernel((void*)fwd_megakernel, dim3(grid_blocks), dim3(NT), args, kDynLds, stream);
  if (e != hipSuccess) fprintf(stderr, "cooperative launch failed: %s (grid %d)\n", hipGetErrorString(e), grid_blocks);
}
```

```cpp
#include <hip/hip_runtime.h>
#include <hip/hip_cooperative_groups.h>
#include <cstdio>
namespace cg = cooperative_groups;

#define LAS __attribute__((address_space(3)))
typedef unsigned short bf16_t;
typedef short bf16x8 __attribute__((ext_vector_type(8)));
typedef float f32x4 __attribute__((ext_vector_type(4)));
typedef float f32x2 __attribute__((ext_vector_type(2)));
typedef unsigned u32x4 __attribute__((ext_vector_type(4)));
typedef unsigned u32x2 __attribute__((ext_vector_type(2)));
typedef float f32x16 __attribute__((ext_vector_type(16)));
#define MFMA32(a, b, c) __builtin_amdgcn_mfma_f32_32x32x16_bf16((a), (b), (c), 0, 0, 0)

constexpr int D = 1024, NB = 8, SEQ = 8192, NTOK = NB * SEQ, GW = 64, ROWS = SEQ / GW;
constexpr int NAH = 8, NADH = 64, NAW = 512, KH = 8, KW = 16;
constexpr int HGH = 4, HGD = 128, HGW = 512;
constexpr int DIN = 6144;
constexpr int NE = 32, EPG = 8, NG = 4, DFF = 512;
constexpr float ALPHA = 1.189207115002721f;
constexpr float LN_EPS = 1e-5f, RMS_EPS = 1e-6f;
constexpr int NT = 512;
constexpr int MAXROWS = NTOK * 2 + NE * 256;
constexpr int MAXMT = MAXROWS / 256;

constexpr size_t MiB = 1u << 20;
constexpr size_t WS_BAR = 65536;
constexpr size_t WS_CTRL = 0;
constexpr size_t WS_WT_IN = 1 * MiB, WS_WT_PA = 13 * MiB, WS_WT_PB = 14 * MiB, WS_WT_OUT = 15 * MiB, WS_WT_GU = 17 * MiB, WS_WT_D = 81 * MiB;
constexpr size_t WS_HB = 113 * MiB;
constexpr size_t WS_ANA = 113 * MiB, WS_CHG = 177 * MiB, WS_HID = 113 * MiB;
constexpr size_t WS_U0 = 241 * MiB;
constexpr size_t WS_NAQ = WS_U0, WS_NAK = WS_U0 + 64 * MiB, WS_NAV = WS_U0 + 128 * MiB, WS_HQ = WS_U0 + 192 * MiB, WS_GF = WS_U0 + 256 * MiB,
                 WS_GB = WS_U0 + 320 * MiB, WS_HI = WS_U0 + 384 * MiB, WS_HG = WS_U0 + 448 * MiB, WS_GA = WS_U0 + 512 * MiB, WS_GBT = WS_U0 + 640 * MiB;
constexpr size_t WS_T1 = 241 * MiB, WS_MERGED = 369 * MiB, WS_H1B = 497 * MiB, WS_XG = 625 * MiB, WS_Y = 625 * MiB;
constexpr size_t WS_STATS = 1009 * MiB, WS_TOKE = 1010 * MiB, WS_TOKP = 1011 * MiB, WS_TOKW = 1012 * MiB, WS_END = 1013 * MiB;

struct Params { const float* in[21]; float* out; unsigned char* ws; };

__device__ __forceinline__ int opq(int v) { asm volatile("" : "+v"(v)); return v; }
template <int CTRL> __device__ __forceinline__ float dpp_mov(float x) { return __uint_as_float((unsigned)__builtin_amdgcn_update_dpp(0, (int)__float_as_uint(x), CTRL, 0xF, 0xF, false)); }
__device__ __forceinline__ float row_sum16(float x) {
  x += dpp_mov<0xB1>(x);
  x += dpp_mov<0x4E>(x);
  x += dpp_mov<0x141>(x);
  x += dpp_mov<0x140>(x);
  return x;
}
__device__ __forceinline__ float lane_bcast(float x, int l) { return __uint_as_float((unsigned)__builtin_amdgcn_readlane((int)__float_as_uint(x), l)); }
__device__ __forceinline__ float wave_sum(float v) {
  v = row_sum16(v);
  return (lane_bcast(v, 0) + lane_bcast(v, 16)) + (lane_bcast(v, 32) + lane_bcast(v, 48));
}
__device__ __forceinline__ float half_swap_max(float x) { const auto r = __builtin_amdgcn_permlane32_swap(__float_as_uint(x), __float_as_uint(x), false, false); return fmaxf(__uint_as_float(r[0]), __uint_as_float(r[1])); }
__device__ __forceinline__ float half_swap_sum(float x) { const auto r = __builtin_amdgcn_permlane32_swap(__float_as_uint(x), __float_as_uint(x), false, false); return __uint_as_float(r[0]) + __uint_as_float(r[1]); }
__device__ __forceinline__ float bf2f(unsigned short b) { return __uint_as_float(((unsigned)b) << 16); }
__device__ __forceinline__ unsigned f2bf(float f) { unsigned u = __float_as_uint(f); return (u + 0x7fffu + ((u >> 16) & 1u)) >> 16; }
__device__ __forceinline__ unsigned pk2(float lo, float hi) { return f2bf(lo) | (f2bf(hi) << 16); }
typedef __bf16 bf16x2_t __attribute__((ext_vector_type(2)));
__device__ __forceinline__ unsigned cvt_pk_bf16(float lo, float hi) { const bf16x2_t v = {(__bf16)lo, (__bf16)hi}; return __builtin_bit_cast(unsigned, v); }
__device__ __forceinline__ unsigned pk2h(float lo, float hi) { const _Float16 a = (_Float16)lo, b = (_Float16)hi; return (unsigned)__builtin_bit_cast(unsigned short, a) | ((unsigned)__builtin_bit_cast(unsigned short, b) << 16); }
__device__ __forceinline__ float h2f(unsigned short h) { return (float)__builtin_bit_cast(_Float16, h); }
__device__ __forceinline__ float sigm(float x) { return __builtin_amdgcn_rcpf(1.0f + __expf(-x)); }
__device__ __forceinline__ float silu(float x) { return x * __builtin_amdgcn_rcpf(1.0f + __expf(-x)); }

namespace pg8 {
constexpr int BM = 256, BK = 64, HALF = 128, HTB = HALF * BK * 2, STAGE_BYTES = 8 * HTB, NXCD = 8, WGM = 8;
__host__ __device__ __forceinline__ int lds_byte(int r, int c) { const int st = (r >> 4) * 2 + (c >> 5), rr = r & 15, cc = c & 31, ob = rr * 64 + cc * 2; return st * 1024 + (ob ^ (((ob >> 9) & 1) << 5)); }
__host__ __device__ __forceinline__ void stage_rc(int b, int& R, int& C) { const int st = b / 1024, sb = b % 1024, swz = sb ^ (((sb >> 9) & 1) << 5); R = (st >> 1) * 16 + swz / 64; C = (st & 1) * 32 + (swz % 64) / 2; }
__host__ __device__ __forceinline__ int perm32(int rho) { const int n = rho >> 4, i = rho & 15; return 8 * (i >> 2) + 4 * n + (i & 3); }

struct Unit { int pm, pn, e; };
struct Gemm { const bf16_t* A; const bf16_t* Bt; int K; size_t b_estride; const bf16_t* A2; const bf16_t* B2; int nt1; const int* rowlist; };

struct StaticOrder {
  int nM, nN, nwg, G, c;
  __device__ void init(int M, int N, int G_, int c_) { nM = M / BM; nN = N / BM; nwg = nM * nN; G = G_; c = c_; }
  __device__ bool next(int i, Unit& u) const {
    const long L = (long)i * G + c; if (L >= nwg) return false;
    int wgid = (int)L; { const int q = nwg / NXCD, r = nwg % NXCD, xcd = wgid % NXCD, off = wgid / NXCD; wgid = (xcd < r ? xcd * (q + 1) : r * (q + 1) + (xcd - r) * q) + off; }
    const int nig = WGM * nN, gid = wgid / nig, fm = gid * WGM, gsz = (nM - fm) < WGM ? (nM - fm) : WGM;
    u.pm = fm + ((wgid % nig) % gsz); u.pn = (wgid % nig) / gsz; u.e = 0; return true;
  }
};
struct GroupedOrder {
  const LAS int* le; int nmt, G, c;
  __device__ bool next(int i, Unit& u) const {
    const int x = c & 7, sidx = c >> 3, pm = i * (G >> 2) + (sidx >> 2) * 8 + x; if (pm >= nmt) return false;
    u.pm = pm; u.pn = sidx & 3; u.e = le[i]; return true;
  }
};
constexpr int GEMM_LE_OFF = 131072;
constexpr int GEMM_RL_OFF = 131072 + 1024;

constexpr bool kSP2 = true;
constexpr bool kALIGN = true;
template <class Epi, class Sched, bool DUAL = false, bool GATHER = false, bool SP2 = kSP2, bool ALIGN_EPI = kALIGN>
__device__ __forceinline__ void gemm_phase(LAS unsigned char* lds, const Gemm g, const Sched& S, const Epi& E, int ntiles = 0) {
  const int tid = opq(threadIdx.x), wid = __builtin_amdgcn_readfirstlane(tid >> 6), lane = tid & 63, wr = wid >> 2, wc = wid & 3, fr = lane & 15, fq = lane >> 4;
  const int K = g.K, nt = DUAL ? ntiles : K / BK;
  unsigned voffA[2], voffB[2];
#pragma unroll
  for (int i = 0; i < 2; ++i) { int R, C; stage_rc(tid * 16 + i * 8192, R, C); const int Rb = Epi::PERM ? ((R & ~31) + perm32(R & 31)) : R;
    voffA[i] = (unsigned)(R * K + C) * 2u; voffB[i] = (unsigned)(Rb * K + C) * 2u; }
  const size_t kstep = (size_t)(BK * 2);
  const size_t hstep = (size_t)HALF * K * 2;
  const size_t tstep = 2 * hstep;
  const unsigned ldsw = (unsigned)wid * 1024u;
  const int aoff = lds_byte(wr * 64 + fr, fq * 8), boff = lds_byte(wc * 32 + fr, fq * 8);
#define PG8_SA(b, h) (((b) * 2 + (h)) * HTB)
#define PG8_SB(b, h) ((4 + (b) * 2 + (h)) * HTB)
#define PG8_STAGE(bufoff, gbase, voff) do { _Pragma("unroll") for (int _i = 0; _i < 2; ++_i) \
    __builtin_amdgcn_global_load_lds((const unsigned*)((const char*)(gbase) + (voff)[_i]), (LAS unsigned*)(lds + (bufoff) + ldsw + _i * 8192), 16, 0, 0); } while (0)
#define PG8_LDA(dst, b, h) do { _Pragma("unroll") for (int m = 0; m < 4; ++m) _Pragma("unroll") for (int k = 0; k < 2; ++k) dst[m][k] = *(const LAS bf16x8*)(lds + PG8_SA(b, h) + aoff + m * 2048 + k * 1024); } while (0)
#define PG8_LDB(dst, b, h) do { _Pragma("unroll") for (int n = 0; n < 2; ++n) _Pragma("unroll") for (int k = 0; k < 2; ++k) dst[n][k] = *(const LAS bf16x8*)(lds + PG8_SB(b, h) + boff + n * 2048 + k * 1024); } while (0)
#define PG8_MMA(ai, bj, At, Bt) do { __builtin_amdgcn_s_setprio(1); _Pragma("unroll") for (int m = 0; m < 4; ++m) _Pragma("unroll") for (int n = 0; n < 2; ++n) _Pragma("unroll") for (int k = 0; k < 2; ++k) \
    acc[ai][bj][m][n] = __builtin_amdgcn_mfma_f32_16x16x32_bf16(Bt[n][k], At[m][k], acc[ai][bj][m][n], 0, 0, 0); __builtin_amdgcn_s_setprio(0); } while (0)
#define PG8_WAIT_V(n) asm volatile("s_waitcnt vmcnt(" #n ")" ::: "memory")
#define PG8_WAIT_L(n) asm volatile("s_waitcnt lgkmcnt(" #n ")" ::: "memory")
#define PG8_BAR __builtin_amdgcn_s_barrier()
#define PG8_SCHED __builtin_amdgcn_sched_barrier(0)
  Unit cur, nxt; int ui = 0;
  if (!S.next(0, cur)) return;
  f32x4 acc[2][2][4][2];
#pragma unroll
  for (int a = 0; a < 2; ++a)
#pragma unroll
    for (int b = 0; b < 2; ++b)
#pragma unroll
      for (int m = 0; m < 4; ++m)
#pragma unroll
        for (int n = 0; n < 2; ++n) acc[a][b][m][n] = (f32x4){0.f, 0.f, 0.f, 0.f};
  bf16x8 At[4][2], B0[2][2], B1[2][2];
  const char* cA = (const char*)g.A + (size_t)cur.pm * tstep; const char* cB = (const char*)g.Bt + (size_t)cur.e * g.b_estride + (size_t)cur.pn * tstep;
  const char* cA2 = DUAL ? (const char*)g.A2 + (size_t)cur.pm * tstep : cA; const char* cB2 = DUAL ? (const char*)g.B2 + (size_t)cur.pn * tstep : cB;
  unsigned gA[2][2] = {{0u, 0u}, {0u, 0u}};
  int gR[2], gC[2];
#pragma unroll
  for (int i = 0; i < 2; ++i) stage_rc(tid * 16 + i * 8192, gR[i], gC[i]);
#define PG8_ROWS(dst, un) do { _Pragma("unroll") for (int h_ = 0; h_ < 2; ++h_) _Pragma("unroll") for (int i_ = 0; i_ < 2; ++i_) \
    dst[h_][i_] = (unsigned)(g.rowlist[(un).pm * BM + h_ * HALF + gR[i_]] * K + gC[i_]) * 2u; } while (0)
  if constexpr (GATHER) { PG8_ROWS(gA, cur); cA = (const char*)g.A; }
#define PG8_RLV(h_, i_) ((unsigned)(*(const LAS int*)(lds + GEMM_RL_OFF + ((ui + 1) & 1) * 1024 + ((h_) * HALF + gR[i_]) * 4) * K + gC[i_]) * 2u)
  if constexpr (SP2) {
    PG8_STAGE(PG8_SB(0, 0), cB, voffB); PG8_STAGE(PG8_SB(0, 1), cB + hstep, voffB);
    if constexpr (GATHER) { PG8_STAGE(PG8_SA(0, 0), cA, gA[0]); PG8_STAGE(PG8_SA(0, 1), cA, gA[1]); } else { PG8_STAGE(PG8_SA(0, 0), cA, voffA); PG8_STAGE(PG8_SA(0, 1), cA + hstep, voffA); }
    if (wr == 1) PG8_BAR;
    PG8_WAIT_V(2); PG8_BAR;
  } else {
  PG8_STAGE(PG8_SB(0, 0), cB, voffB); if constexpr (GATHER) PG8_STAGE(PG8_SA(0, 0), cA, gA[0]); else PG8_STAGE(PG8_SA(0, 0), cA, voffA);
  PG8_STAGE(PG8_SB(0, 1), cB + hstep, voffB); if constexpr (GATHER) PG8_STAGE(PG8_SA(0, 1), cA, gA[1]); else PG8_STAGE(PG8_SA(0, 1), cA + hstep, voffA);
  if (wr == 1) PG8_BAR;
  PG8_WAIT_V(4); PG8_BAR;
  }
  PG8_STAGE(PG8_SB(1, 0), cB + kstep, voffB); if constexpr (GATHER) PG8_STAGE(PG8_SA(1, 0), cA + kstep, gA[0]); else PG8_STAGE(PG8_SA(1, 0), cA + kstep, voffA);
  PG8_STAGE(PG8_SB(1, 1), cB + hstep + kstep, voffB);
  PG8_WAIT_V(6); PG8_BAR;
  for (;;) {
    const bool has_next = S.next(ui + 1, nxt);
    const char* nA = GATHER ? (const char*)g.A : (has_next ? (const char*)g.A + (size_t)nxt.pm * tstep : cA);
    if constexpr (GATHER) {
      if (has_next && wid == 0) __builtin_amdgcn_global_load_lds((const unsigned*)(g.rowlist + nxt.pm * BM) + lane * 4, (LAS unsigned*)(lds + GEMM_RL_OFF + ((ui + 1) & 1) * 1024), 16, 0, 0); }
    const char* nB = has_next ? (const char*)g.Bt + (size_t)nxt.e * g.b_estride + (size_t)nxt.pn * tstep : cB;
    for (int t = 0; t < nt; t += 2) {
      const bool last = (t == nt - 2);
      const char* a1 = (DUAL && t >= g.nt1) ? cA2 + (size_t)(t + 1 - g.nt1) * kstep : cA + (size_t)(t + 1) * kstep;
      const char* a2 = last ? nA : ((DUAL && t + 2 >= g.nt1) ? cA2 + (size_t)(t + 2 - g.nt1) * kstep : cA + (size_t)(t + 2) * kstep);
      const char* b2 = last ? nB : ((DUAL && t + 2 >= g.nt1) ? cB2 + (size_t)(t + 2 - g.nt1) * kstep : cB + (size_t)(t + 2) * kstep);
      const char* a3 = a2 + kstep; const char* b3 = b2 + kstep;
      if constexpr (DUAL) { if (t == g.nt1) E.mid(acc, cur, wr, wc, fr, fq); }
      unsigned vA0[2], vA1[2];
      if constexpr (GATHER) { const bool ln_ = last && has_next; _Pragma("unroll") for (int i_ = 0; i_ < 2; ++i_) { const unsigned n0_ = PG8_RLV(0, i_), n1_ = PG8_RLV(1, i_); vA0[i_] = ln_ ? n0_ : gA[0][i_]; vA1[i_] = ln_ ? n1_ : gA[1][i_]; } }
      if constexpr (SP2) {
      PG8_LDB(B0, 0, 0); PG8_LDB(B1, 0, 1); PG8_SCHED; PG8_LDA(At, 0, 0); if constexpr (GATHER) PG8_STAGE(PG8_SA(1, 1), a1, gA[1]); else PG8_STAGE(PG8_SA(1, 1), a1 + hstep, voffA);
      PG8_WAIT_V(8); PG8_WAIT_L(0); PG8_BAR; PG8_MMA(0, 0, At, B0); PG8_MMA(0, 1, At, B1); PG8_BAR; PG8_SCHED;
      PG8_LDA(At, 0, 1); PG8_STAGE(PG8_SB(0, 0), b2, voffB); PG8_STAGE(PG8_SB(0, 1), b2 + hstep, voffB); if constexpr (GATHER) PG8_STAGE(PG8_SA(0, 0), a2, vA0); else PG8_STAGE(PG8_SA(0, 0), a2, voffA);
      PG8_WAIT_V(8); PG8_WAIT_L(0); PG8_BAR; PG8_MMA(1, 0, At, B0); PG8_MMA(1, 1, At, B1); PG8_BAR; PG8_SCHED;
      PG8_LDB(B0, 1, 0); PG8_LDB(B1, 1, 1); PG8_SCHED; PG8_LDA(At, 1, 0); if constexpr (GATHER) PG8_STAGE(PG8_SA(0, 1), a2, vA1); else PG8_STAGE(PG8_SA(0, 1), a2 + hstep, voffA);
      PG8_WAIT_V(8); PG8_WAIT_L(0); PG8_BAR; PG8_MMA(0, 0, At, B0); PG8_MMA(0, 1, At, B1); PG8_BAR; PG8_SCHED;
      PG8_LDA(At, 1, 1); PG8_STAGE(PG8_SB(1, 0), b3, voffB); PG8_STAGE(PG8_SB(1, 1), b3 + hstep, voffB); if constexpr (GATHER) PG8_STAGE(PG8_SA(1, 0), a3, vA0); else PG8_STAGE(PG8_SA(1, 0), a3, voffA);
      PG8_WAIT_V(8); PG8_WAIT_L(0); PG8_BAR; PG8_MMA(1, 0, At, B0); PG8_MMA(1, 1, At, B1); PG8_BAR; PG8_SCHED;
      } else {
      PG8_LDB(B0, 0, 0); PG8_SCHED; PG8_LDA(At, 0, 0); if constexpr (GATHER) PG8_STAGE(PG8_SA(1, 1), a1, gA[1]); else PG8_STAGE(PG8_SA(1, 1), a1 + hstep, voffA);
      PG8_WAIT_L(8); PG8_BAR; PG8_WAIT_L(0); PG8_MMA(0, 0, At, B0); PG8_BAR; PG8_SCHED;
      PG8_LDB(B1, 0, 1); PG8_STAGE(PG8_SB(0, 0), b2, voffB);
      PG8_BAR; PG8_WAIT_L(0); PG8_MMA(0, 1, At, B1); PG8_BAR;
      PG8_LDA(At, 0, 1); if constexpr (GATHER) PG8_STAGE(PG8_SA(0, 0), a2, vA0); else PG8_STAGE(PG8_SA(0, 0), a2, voffA);
      PG8_BAR; PG8_WAIT_L(0); PG8_MMA(1, 0, At, B0); PG8_BAR; PG8_SCHED;
      PG8_STAGE(PG8_SB(0, 1), b2 + hstep, voffB);
      PG8_WAIT_V(6); PG8_BAR; PG8_MMA(1, 1, At, B1); PG8_BAR;
      PG8_LDB(B0, 1, 0); PG8_SCHED; PG8_LDA(At, 1, 0); if constexpr (GATHER) PG8_STAGE(PG8_SA(0, 1), a2, vA1); else PG8_STAGE(PG8_SA(0, 1), a2 + hstep, voffA);
      PG8_WAIT_L(8); PG8_BAR; PG8_WAIT_L(0); PG8_MMA(0, 0, At, B0); PG8_BAR; PG8_SCHED;
      PG8_LDB(B1, 1, 1); PG8_STAGE(PG8_SB(1, 0), b3, voffB);
      PG8_BAR; PG8_WAIT_L(0); PG8_MMA(0, 1, At, B1); PG8_BAR;
      PG8_LDA(At, 1, 1); if constexpr (GATHER) PG8_STAGE(PG8_SA(1, 0), a3, vA0); else PG8_STAGE(PG8_SA(1, 0), a3, voffA);
      PG8_BAR; PG8_WAIT_L(0); PG8_MMA(1, 0, At, B0); PG8_BAR; PG8_SCHED;
      PG8_STAGE(PG8_SB(1, 1), b3 + hstep, voffB);
      PG8_WAIT_V(6); PG8_BAR; PG8_MMA(1, 1, At, B1); PG8_BAR;
      }
    }
    if constexpr (ALIGN_EPI) { if (wr == 0) PG8_BAR; }
    E(acc, cur, wr, wc, fr, fq);
    if (!has_next) break;
#pragma unroll
    for (int a = 0; a < 2; ++a)
#pragma unroll
      for (int b = 0; b < 2; ++b)
#pragma unroll
        for (int m = 0; m < 4; ++m)
#pragma unroll
          for (int n = 0; n < 2; ++n) acc[a][b][m][n] = (f32x4){0.f, 0.f, 0.f, 0.f};
    if constexpr (GATHER) { _Pragma("unroll") for (int h_ = 0; h_ < 2; ++h_) _Pragma("unroll") for (int i_ = 0; i_ < 2; ++i_) gA[h_][i_] = PG8_RLV(h_, i_); }
    cur = nxt; cA = nA; cB = nB; ++ui;
    if constexpr (ALIGN_EPI) { if (wr == 1) PG8_BAR; }
    if (DUAL) { cA2 = (const char*)g.A2 + (size_t)cur.pm * tstep; cB2 = (const char*)g.B2 + (size_t)cur.pn * tstep; }
  }
  PG8_WAIT_V(0);
  if constexpr (!ALIGN_EPI) { if (wr == 0) PG8_BAR; }
  PG8_BAR;
#undef PG8_ROWS
#undef PG8_RLV
#undef PG8_SA
#undef PG8_SB
#undef PG8_STAGE
#undef PG8_LDA
#undef PG8_LDB
#undef PG8_MMA
#undef PG8_WAIT_V
#undef PG8_WAIT_L
#undef PG8_BAR
#undef PG8_SCHED
}

struct EpiU {
  static constexpr bool PERM = true;
  unsigned char* ubase; LAS unsigned char* scr; const LAS float* lb;
  __device__ __forceinline__ void run_kb(const f32x4 (&acc)[2][2][4][2], unsigned char* base, int row0, int col0) const {
    bf16_t* KB = (bf16_t*)base;
#pragma unroll
    for (int ai = 0; ai < 2; ++ai)
#pragma unroll
      for (int m = 0; m < 4; ++m) {
        const int t = row0 + ai * HALF + m * 16, tb8 = (t >> 13) * 8, grow = (t >> 6) & 127, c = t & 63;
#pragma unroll
        for (int bj = 0; bj < 2; ++bj) {
          const int kcol = col0 + bj * HALF;
          const f32x4 v0 = acc[ai][bj][m][0], v1 = acc[ai][bj][m][1];
          u32x4 w; w.x = cvt_pk_bf16(v0[0], v0[1]); w.y = cvt_pk_bf16(v0[2], v0[3]); w.z = cvt_pk_bf16(v1[0], v1[1]); w.w = cvt_pk_bf16(v1[2], v1[3]);
          *(u32x4*)(KB + ((size_t)(((tb8 + (kcol >> 6)) * 128 + grow) * 8 + ((kcol & 63) >> 3)) * 64 + c) * 8) = w;
        }
      }
  }
  __device__ __forceinline__ void run_vt(const f32x4 (&acc)[2][2][4][2], unsigned char* base, int row0, int col0, LAS unsigned char* scr, int fr, int fq) const {
    bf16_t* VT = (bf16_t*)base; const int lane = fq * 16 + fr, cb = col0 - 8 * fq;
#pragma unroll
    for (int ai = 0; ai < 2; ++ai) {
      const int t = (row0 - fr) + ai * HALF, tb8 = (t >> 13) * 8, grow = (t >> 6) & 127;
#pragma unroll
      for (int bj = 0; bj < 2; ++bj)
#pragma unroll
        for (int n = 0; n < 2; ++n) {
#pragma unroll
          for (int m = 0; m < 4; ++m)
#pragma unroll
            for (int j = 0; j < 4; ++j)
              *(LAS unsigned short*)(scr + ((((2 * m + (fr >> 3)) * 16 + 4 * fq + j) * 8) + (fr & 7)) * 2) = __builtin_bit_cast(unsigned short, (__bf16)acc[ai][bj][m][n][j]);
#pragma unroll
          for (int k = 0; k < 2; ++k) {
            const int q = lane + 64 * k, colblk = q >> 4, dl = q & 15;
            const u32x4 w = *(const LAS u32x4*)(scr + q * 16);
            const int vcol = cb + bj * HALF + 8 * (dl >> 2) + 4 * n + (dl & 3);
            *(u32x4*)(VT + ((size_t)(((tb8 + (vcol >> 6)) * 128 + grow) * 8 + colblk) * 64 + (vcol & 63)) * 8) = w;
          }
        }
    }
  }
  __device__ __forceinline__ void run_hit(const f32x4 (&acc)[2][2][4][2], unsigned char* base, int row0, int col0, LAS unsigned char* scr, int fr, int fq) const {
    bf16_t* HT = (bf16_t*)base; const int lane = fq * 16 + fr, cb = col0 - 8 * fq;
#pragma unroll
    for (int ai = 0; ai < 2; ++ai) {
      const int t = (row0 - fr) + ai * HALF, tb4 = (t >> 13) * 4, blk = (t >> 6) & 127;
#pragma unroll
      for (int bj = 0; bj < 2; ++bj)
#pragma unroll
        for (int n = 0; n < 2; ++n) {
#pragma unroll
          for (int m = 0; m < 4; ++m)
#pragma unroll
            for (int j = 0; j < 4; ++j)
              *(LAS unsigned short*)(scr + ((4 * fq + j) * 64 + 16 * m + fr) * 2) = __builtin_bit_cast(unsigned short, (__bf16)acc[ai][bj][m][n][j]);
#pragma unroll
          for (int k = 0; k < 2; ++k) {
            const int q = lane + 64 * k, vl = q >> 3, pc = q & 7;
            const u32x4 w = *(const LAS u32x4*)(scr + q * 16);
            const int hcol = cb + bj * HALF + 8 * (vl >> 2) + 4 * n + (vl & 3);
            *(u32x4*)(HT + ((size_t)((tb4 + (hcol >> 7)) * 128 + blk) * 128 + (hcol & 127)) * 64 + pc * 8) = w;
          }
        }
    }
  }
  template <int MODE>
  __device__ __forceinline__ void run(const f32x4 (&acc)[2][2][4][2], unsigned char* base, int ld, int row0, int col0, int lbcol0) const {
    f32x4 lbv[2][2];
    if (MODE == 2) {
#pragma unroll
      for (int bj = 0; bj < 2; ++bj)
#pragma unroll
        for (int n = 0; n < 2; ++n) lbv[bj][n] = *(const LAS f32x4*)(lb + lbcol0 + bj * HALF + 4 * n);
    }
#pragma unroll
    for (int ai = 0; ai < 2; ++ai)
#pragma unroll
      for (int m = 0; m < 4; ++m) {
        unsigned char* rowp = base + ((size_t)(row0 + ai * HALF + m * 16) * ld + col0) * 2;
#pragma unroll
        for (int bj = 0; bj < 2; ++bj) {
          f32x4 v[2] = {acc[ai][bj][m][0], acc[ai][bj][m][1]};
          u32x4 w;
#pragma unroll
          for (int n = 0; n < 2; ++n)
#pragma unroll
            for (int j = 0; j < 4; ++j) {
              float x = v[n][j];
              if (MODE == 1) x = silu(x);
              if (MODE == 2) { const float l = lbv[bj][n][j]; x = __logf(l + (1.f - l) * sigm(x)); }
              if (MODE == 3) x = sigm(x);
              if (MODE == 4) x *= 0.125f * 1.4426950408889634f;
              v[n][j] = x;
            }
          if (MODE == 2) { w.x = pk2h(v[0][0], v[0][1]); w.y = pk2h(v[0][2], v[0][3]); w.z = pk2h(v[1][0], v[1][1]); w.w = pk2h(v[1][2], v[1][3]); }
          else { w.x = cvt_pk_bf16(v[0][0], v[0][1]); w.y = cvt_pk_bf16(v[0][2], v[0][3]); w.z = cvt_pk_bf16(v[1][0], v[1][1]); w.w = cvt_pk_bf16(v[1][2], v[1][3]); }
          *(u32x4*)(rowp + bj * HALF * 2) = w;
        }
      }
  }
  __device__ __forceinline__ void operator()(const f32x4 (&acc)[2][2][4][2], const Unit& u, int wr, int wc, int fr, int fq) const {
    const int pn = u.pn, row0 = u.pm * BM + wr * 64 + fr, cw = wc * 32 + 8 * fq;
    if (pn < 16) {
      const int seg = pn >> 1; unsigned char* base = ubase + (size_t)seg * 64 * MiB; const int col0 = (pn & 1) * 256 + cw;
      if (seg == 0) run<4>(acc, base, 512, row0, col0, 0);
      else if (seg == 1) run_kb(acc, base, row0, col0);
      else if (seg == 2) run_vt(acc, base, row0, col0, scr + (wr * 4 + wc) * 2048, fr, fq);
      else if (seg == 6) run_hit(acc, base, row0, col0, scr + (wr * 4 + wc) * 2048, fr, fq);
      else if (seg == 3 || seg == 7) run<1>(acc, base, 512, row0, col0, 0);
      else if (seg == 4 || seg == 5) run<2>(acc, base, 512, row0, col0, (seg - 4) * 512 + col0);
      else run<0>(acc, base, 512, row0, col0, 0);
    } else {
      bf16_t* GAp = (bf16_t*)(ubase + 512 * MiB); bf16_t* RHp = (bf16_t*)(ubase + 640 * MiB);
      const int col0 = (pn - 16) * 128 + cw;
#pragma unroll
      for (int ai = 0; ai < 2; ++ai)
#pragma unroll
        for (int m = 0; m < 4; ++m) {
          const size_t ro = (size_t)(row0 + ai * HALF + m * 16) * 1024 + col0;
          float ga[8], rh[8];
#pragma unroll
          for (int n = 0; n < 2; ++n)
#pragma unroll
            for (int j = 0; j < 4; ++j) {
              const float ea = 1.f + __expf(-acc[ai][0][m][n][j]), eb = 1.f + __expf(-acc[ai][1][m][n][j]);
              ga[4 * n + j] = __builtin_amdgcn_rcpf(ea); rh[4 * n + j] = ea * __builtin_amdgcn_rcpf(eb);
            }
          u32x4 w; w.x = cvt_pk_bf16(ga[0], ga[1]); w.y = cvt_pk_bf16(ga[2], ga[3]); w.z = cvt_pk_bf16(ga[4], ga[5]); w.w = cvt_pk_bf16(ga[6], ga[7]);
          *(u32x4*)(GAp + ro) = w;
          w.x = cvt_pk_bf16(rh[0], rh[1]); w.y = cvt_pk_bf16(rh[2], rh[3]); w.z = cvt_pk_bf16(rh[4], rh[5]); w.w = cvt_pk_bf16(rh[6], rh[7]);
          *(u32x4*)(RHp + ro) = w;
        }
    }
  }
};
template <int MODE> struct EpiGate {
  static constexpr bool PERM = true;
  const bf16_t* G1; const bf16_t* T; bf16_t* O;
  __device__ __forceinline__ void mid(f32x4 (&acc)[2][2][4][2], const Unit& u, int wr, int wc, int fr, int fq) const {
    const int row0 = u.pm * BM + wr * 64 + fr, col0 = u.pn * BM + wc * 32 + 8 * fq;
#pragma unroll
    for (int ai = 0; ai < 2; ++ai) {
      u32x4 rv[4][2];
#pragma unroll
      for (int m = 0; m < 4; ++m)
#pragma unroll
        for (int bj = 0; bj < 2; ++bj) rv[m][bj] = *(const u32x4*)(T + (size_t)(row0 + ai * HALF + m * 16) * D + col0 + bj * HALF);
      asm volatile("" : "+v"(rv[0][0]), "+v"(rv[0][1]), "+v"(rv[1][0]), "+v"(rv[1][1]), "+v"(rv[2][0]), "+v"(rv[2][1]), "+v"(rv[3][0]), "+v"(rv[3][1]));
#pragma unroll
      for (int m = 0; m < 4; ++m)
#pragma unroll
        for (int bj = 0; bj < 2; ++bj)
#pragma unroll
          for (int q = 0; q < 4; ++q) {
            const float r0 = __uint_as_float(rv[m][bj][q] << 16), r1 = __uint_as_float(rv[m][bj][q] & 0xffff0000u);
            if (q < 2) { acc[ai][bj][m][0][2 * q] *= r0; acc[ai][bj][m][0][2 * q + 1] *= r1; }
            else { acc[ai][bj][m][1][2 * q - 4] *= r0; acc[ai][bj][m][1][2 * q - 3] *= r1; }
          }
    }
  }
  __device__ __forceinline__ void operator()(const f32x4 (&acc)[2][2][4][2], const Unit& u, int wr, int wc, int fr, int fq) const {
    const int row0 = u.pm * BM + wr * 64 + fr, col0 = u.pn * BM + wc * 32 + 8 * fq;
#pragma unroll
    for (int ai = 0; ai < 2; ++ai) {
      u32x4 gvv[4][2], tvv[4][2];
#pragma unroll
      for (int m = 0; m < 4; ++m)
#pragma unroll
        for (int bj = 0; bj < 2; ++bj) {
          const size_t ro = (size_t)(row0 + ai * HALF + m * 16) * D + col0 + bj * HALF;
          gvv[m][bj] = *(const u32x4*)(G1 + ro);
          if constexpr (MODE == 1) tvv[m][bj] = *(const u32x4*)(T + ro);
        }
      asm volatile("" : "+v"(gvv[0][0]), "+v"(gvv[0][1]), "+v"(gvv[1][0]), "+v"(gvv[1][1]), "+v"(gvv[2][0]), "+v"(gvv[2][1]), "+v"(gvv[3][0]), "+v"(gvv[3][1]));
#pragma unroll
      for (int m = 0; m < 4; ++m)
#pragma unroll
        for (int bj = 0; bj < 2; ++bj) {
          const size_t ro = (size_t)(row0 + ai * HALF + m * 16) * D + col0 + bj * HALF;
          const u32x4 gv = gvv[m][bj]; u32x4 tv = (u32x4){0u, 0u, 0u, 0u}; if constexpr (MODE == 1) tv = tvv[m][bj];
          const f32x4 v0 = acc[ai][bj][m][0], v1 = acc[ai][bj][m][1];
          const float a8[8] = {v0[0], v0[1], v0[2], v0[3], v1[0], v1[1], v1[2], v1[3]};
          float o[8];
#pragma unroll
          for (int q = 0; q < 4; ++q) {
            const float g0 = __uint_as_float(gv[q] << 16), g1 = __uint_as_float(gv[q] & 0xffff0000u);
            float r0 = g0 * a8[2 * q], r1 = g1 * a8[2 * q + 1];
            if (MODE == 1) { r0 += __uint_as_float(tv[q] << 16); r1 += __uint_as_float(tv[q] & 0xffff0000u); }
            o[2 * q] = r0; o[2 * q + 1] = r1;
          }
          u32x4 w; w.x = cvt_pk_bf16(o[0], o[1]); w.y = cvt_pk_bf16(o[2], o[3]); w.z = cvt_pk_bf16(o[4], o[5]); w.w = cvt_pk_bf16(o[6], o[7]);
          *(u32x4*)(O + ro) = w;
        }
    }
  }
};
struct EpiRes {
  static constexpr bool PERM = true;
  const float* x; const float* stats; const float* g; const float* b; float* O;
  __device__ __forceinline__ void operator()(const f32x4 (&acc)[2][2][4][2], const Unit& u, int wr, int wc, int fr, int fq) const {
    const int row0 = u.pm * BM + wr * 64 + fr, col0 = u.pn * BM + wc * 32 + 8 * fq;
    f32x4 gv[2][2], bv[2][2];
#pragma unroll
    for (int bj = 0; bj < 2; ++bj)
#pragma unroll
      for (int n = 0; n < 2; ++n) { gv[bj][n] = *(const f32x4*)(g + col0 + bj * HALF + n * 4) * ALPHA; bv[bj][n] = *(const f32x4*)(b + col0 + bj * HALF + n * 4) * ALPHA; }
#pragma unroll
    for (int ai = 0; ai < 2; ++ai)
#pragma unroll
      for (int m = 0; m < 4; ++m) {
        const int r = row0 + ai * HALF + m * 16; const f32x2 st = *(const f32x2*)(stats + 2 * (size_t)r);
        const size_t ro = (size_t)r * D + col0;
#pragma unroll
        for (int bj = 0; bj < 2; ++bj)
#pragma unroll
          for (int n = 0; n < 2; ++n) {
            const f32x4 xv = *(const f32x4*)(x + ro + bj * HALF + n * 4);
            *(f32x4*)(O + ro + bj * HALF + n * 4) = ((xv - st.x) * st.y) * gv[bj][n] + bv[bj][n] + acc[ai][bj][m][n];
          }
      }
  }
};
struct EpiSwiGLU {
  static constexpr bool PERM = true;
  bf16_t* HID;
  __device__ __forceinline__ void operator()(const f32x4 (&acc)[2][2][4][2], const Unit& u, int wr, int wc, int fr, int fq) const {
    const int row0 = u.pm * BM + wr * 64 + fr, col0 = u.pn * 128 + wc * 32 + 8 * fq;
#pragma unroll
    for (int ai = 0; ai < 2; ++ai)
#pragma unroll
      for (int m = 0; m < 4; ++m) {
        float o[8];
#pragma unroll
        for (int n = 0; n < 2; ++n)
#pragma unroll
          for (int j = 0; j < 4; ++j) o[4 * n + j] = silu(acc[ai][0][m][n][j]) * acc[ai][1][m][n][j];
        u32x4 w; w.x = cvt_pk_bf16(o[0], o[1]); w.y = cvt_pk_bf16(o[2], o[3]); w.z = cvt_pk_bf16(o[4], o[5]); w.w = cvt_pk_bf16(o[6], o[7]);
        *(u32x4*)(HID + (size_t)(row0 + ai * HALF + m * 16) * DFF + col0) = w;
      }
  }
};
struct EpiBf16 {
  static constexpr bool PERM = true;
  bf16_t* O; int ldc;
  __device__ __forceinline__ void operator()(const f32x4 (&acc)[2][2][4][2], const Unit& u, int wr, int wc, int fr, int fq) const {
    const int row0 = u.pm * BM + wr * 64 + fr, col0 = u.pn * BM + wc * 32 + 8 * fq;
#pragma unroll
    for (int ai = 0; ai < 2; ++ai)
#pragma unroll
      for (int m = 0; m < 4; ++m) {
        bf16_t* rowp = O + (size_t)(row0 + ai * HALF + m * 16) * ldc + col0;
#pragma unroll
        for (int bj = 0; bj < 2; ++bj) {
          const f32x4 v0 = acc[ai][bj][m][0], v1 = acc[ai][bj][m][1];
          u32x4 w; w.x = cvt_pk_bf16(v0[0], v0[1]); w.y = cvt_pk_bf16(v0[2], v0[3]); w.z = cvt_pk_bf16(v1[0], v1[1]); w.w = cvt_pk_bf16(v1[2], v1[3]);
          *(u32x4*)(rowp + bj * HALF) = w;
        }
      }
  }
};
}

__device__ __forceinline__ void p0_transpose_item(const float* W, int K, int N, bf16_t* WT, int k0, int n0, int drow0, LAS float* scr, int lane) {
  f32x4 v[8];
#pragma unroll
  for (int i = 0; i < 8; ++i) v[i] = *(const f32x4*)(W + (size_t)(k0 + (lane >> 3) + 8 * i) * N + n0 + (lane & 7) * 4);
#pragma unroll
  for (int i = 0; i < 8; ++i) { LAS float* d = scr + ((lane >> 3) + 8 * i) * 33 + (lane & 7) * 4; d[0] = v[i].x; d[1] = v[i].y; d[2] = v[i].z; d[3] = v[i].w; }
  asm volatile("s_waitcnt lgkmcnt(0)" ::: "memory");
  const int c = lane & 7;
#pragma unroll
  for (int j = 0; j < 4; ++j) { const int n = (lane >> 3) + 8 * j; const LAS float* s = scr + (8 * c) * 33 + n;
    u32x4 o; o.x = pk2(s[0 * 33], s[1 * 33]); o.y = pk2(s[2 * 33], s[3 * 33]); o.z = pk2(s[4 * 33], s[5 * 33]); o.w = pk2(s[6 * 33], s[7 * 33]);
    *(u32x4*)(WT + (size_t)(drow0 + n) * K + k0 + 8 * c) = o; }
  asm volatile("s_waitcnt lgkmcnt(0)" ::: "memory");
}

struct P0Ptrs { const float *w_in, *wpa, *wpb, *w_out, *w_gate, *w_up, *w_down; bf16_t *WT_in, *WT_pa, *WT_pb, *WT_out, *WT_gu, *WT_d; };
__device__ __forceinline__ void p0_decode(const P0Ptrs& P, int it, const float*& src, int& N_, bf16_t*& dst, int& K_) {
  constexpr int I_IN = (D / 64) * (DIN / 32), I_PA = (NAW / 64) * (D / 32), I_OUT = (D / 64) * (D / 32), I_GU = (D / 64) * (DFF / 32), I_DN = (DFF / 64) * (D / 32);
  int r = it;
  if (r < I_IN) { const int nb = DIN / 32, kb = r / nb, n0 = (r % nb) * 32;
    int drow = n0; if (n0 >= 4096) { const int j0 = (n0 - 4096) & 1023; drow = 4096 + (j0 >> 7) * 256 + (n0 >= 5120 ? 128 : 0) + (j0 & 127); }
    src = P.w_in + (size_t)(kb * 64) * DIN + n0; N_ = DIN; dst = P.WT_in + (size_t)drow * D + kb * 64; K_ = D; return; } r -= I_IN;
  if (r < I_PA) { const int nb = D / 32, kb = r / nb, n0 = (r % nb) * 32; src = P.wpa + (size_t)(kb * 64) * D + n0; N_ = D; dst = P.WT_pa + (size_t)n0 * NAW + kb * 64; K_ = NAW; return; } r -= I_PA;
  if (r < I_PA) { const int nb = D / 32, kb = r / nb, n0 = (r % nb) * 32; src = P.wpb + (size_t)(kb * 64) * D + n0; N_ = D; dst = P.WT_pb + (size_t)n0 * HGW + kb * 64; K_ = HGW; return; } r -= I_PA;
  if (r < I_OUT) { const int nb = D / 32, kb = r / nb, n0 = (r % nb) * 32; src = P.w_out + (size_t)(kb * 64) * D + n0; N_ = D; dst = P.WT_out + (size_t)n0 * D + kb * 64; K_ = D; return; } r -= I_OUT;
  const int e = r / (2 * I_GU + I_DN); r -= e * (2 * I_GU + I_DN);
  if (r < 2 * I_GU) {
    const int up = r >= I_GU; if (up) r -= I_GU;
    const int nb = DFF / 32, kb = r / nb, n0 = (r % nb) * 32;
    src = (up ? P.w_up : P.w_gate) + (size_t)e * D * DFF + (size_t)(kb * 64) * DFF + n0; N_ = DFF;
    dst = P.WT_gu + (size_t)(e * 1024 + (n0 >> 7) * 256 + up * 128 + (n0 & 127)) * D + kb * 64; K_ = D;
  } else { r -= 2 * I_GU; const int nb = D / 32, kb = r / nb, n0 = (r % nb) * 32;
    src = P.w_down + (size_t)e * DFF * D + (size_t)(kb * 64) * D + n0; N_ = D; dst = P.WT_d + (size_t)(e * 1024 + n0) * DFF + kb * 64; K_ = DFF; }
}

constexpr int SC_QP = 0;
constexpr int SC_KP = SC_QP + 64 * 272;
constexpr int SC_KT = SC_KP + 64 * 272;
constexpr int SC_VT = SC_KT + 128 * 144;
constexpr int SC_A = SC_VT + 128 * 144;
constexpr int SC_ST = SC_A + 64 * 144;
constexpr int SC_EB = SC_ST + 128 * 272;
constexpr int SC_TOT = SC_EB + 512;
constexpr int SC_END = SC_TOT + 4096;
static_assert(SC_END <= 131072, "scan LDS map");
__device__ __forceinline__ bf16x8 ldfrag(LAS unsigned char* base, int stride, int row, int kel) { return *(const LAS bf16x8*)(base + row * stride + kel * 2); }


#define XB_TMO      128
#define XB_XCNT(j)  (256  + 64 * (j))
#define XB_XSUB(j)  (1280 + 64 * (j))
#define XB_XGEN(j)  (2304 + 64 * (j))
#define XB_TOP      3328
#define XB_TOPGEN   3392
#define XCD_BAR_WORDS 3456
#define XB_SPIN_CAP (1u << 20)
__device__ __forceinline__ unsigned xb_ld(unsigned* p)              { return __hip_atomic_load(p, __ATOMIC_RELAXED, __HIP_MEMORY_SCOPE_AGENT); }
__device__ __forceinline__ unsigned xb_add(unsigned* p, unsigned v) { return __hip_atomic_fetch_add(p, v, __ATOMIC_RELAXED, __HIP_MEMORY_SCOPE_AGENT); }
__device__ __forceinline__ unsigned xb_xcc_id() { return (unsigned)__builtin_amdgcn_s_getreg((3 << 11) | 20) & 0xFu; }
#define XB_SPIN(cond, bar) do { unsigned _sp = 0; while (cond) { __builtin_amdgcn_s_sleep(1); \
    if ((++_sp & 255u) == 0u) { if (xb_ld(&(bar)[XB_TMO])) break; if (_sp > XB_SPIN_CAP) { atomicAdd(&(bar)[XB_TMO], 1u); break; } } } } while (0)
struct XcdBarrier { unsigned* bar; unsigned x; volatile LAS unsigned* st; };
__device__ __forceinline__ XcdBarrier xcd_barrier_post(unsigned* bar, volatile LAS unsigned* st) {
  XcdBarrier b; b.bar = bar; b.x = xb_xcc_id(); b.st = st;
  if (threadIdx.x == 0) (void)xb_add(&bar[XB_XCNT(b.x)], 1u);
  return b;
}
__device__ __forceinline__ void xcd_barrier_complete(unsigned* bar, unsigned x, unsigned& nloc, unsigned& nx) {
  const unsigned G = gridDim.x * gridDim.y * gridDim.z;
  unsigned sum, cnt, mine, sp = 0u;
  for (;;) {
    sum = 0u; cnt = 0u; mine = 0u;
#pragma unroll
    for (unsigned j = 0; j < 16; ++j) { const unsigned c = xb_ld(&bar[XB_XCNT(j)]); sum += c; cnt += (c > 0u) ? 1u : 0u; mine = (j == x) ? c : mine; }
    if (sum == G) break;
    __builtin_amdgcn_s_sleep(1);
    if ((++sp & 255u) == 0u) { if (xb_ld(&bar[XB_TMO])) break; if (sp > XB_SPIN_CAP) { atomicAdd(&bar[XB_TMO], 1u); break; } }
  }
  nloc = mine > 0u ? mine : 1u; nx = cnt > 0u ? cnt : 1u;
}
__device__ __forceinline__ void xcd_barrier(const XcdBarrier& b) {
  asm volatile("s_waitcnt vmcnt(0)" ::: "memory");
  __syncthreads();
  if (threadIdx.x == 0) {
    unsigned* bar = b.bar;
    __builtin_amdgcn_s_waitcnt(0);
    unsigned nloc = b.st[0], nx = b.st[1];
    if (nloc == 0u) { xcd_barrier_complete(bar, b.x, nloc, nx); b.st[0] = nloc; b.st[1] = nx; }
    const unsigned old = xb_add(&bar[XB_XSUB(b.x)], 1u);
    const unsigned gen = old / nloc;
    if (old + 1u == (gen + 1u) * nloc) {
      __builtin_amdgcn_fence(__ATOMIC_RELEASE, "agent");
      asm volatile("s_waitcnt vmcnt(0)" ::: "memory");
      const unsigned og = xb_add(&bar[XB_TOP], 1u);
      const unsigned tg = og / nx;
      if (og + 1u == (tg + 1u) * nx) xb_add(&bar[XB_TOPGEN], 1u);
      else XB_SPIN(xb_ld(&bar[XB_TOPGEN]) == tg, bar);
      __builtin_amdgcn_fence(__ATOMIC_ACQUIRE, "agent");
      xb_add(&bar[XB_XGEN(b.x)], 1u);
      asm volatile("s_waitcnt vmcnt(0)" ::: "memory");
    } else {
      XB_SPIN(xb_ld(&bar[XB_XGEN(b.x)]) == gen, bar);
      __builtin_amdgcn_fence(__ATOMIC_ACQUIRE, "agent");
      asm volatile("s_waitcnt vmcnt(0)" ::: "memory");
    }
  }
  __syncthreads();
}

constexpr int LDS_BYTES = 157696;
__global__ void __launch_bounds__(NT, 2) fwd_megakernel(Params p) {
  cg::grid_group grid = cg::this_grid();
  extern __shared__ __attribute__((aligned(16))) unsigned char lds_raw[];
  LAS unsigned char* lds = (LAS unsigned char*)lds_raw;
  const int G = gridDim.x, bid = blockIdx.x, NGW = G * (NT / 64);
  volatile LAS unsigned* bst = (volatile LAS unsigned*)(lds + LDS_BYTES - 16);
  if (threadIdx.x < 4) bst[threadIdx.x] = 0u;
  __syncthreads();
  if (bid == 0) for (int i = threadIdx.x; i < 4096; i += NT) __hip_atomic_store((unsigned*)(p.ws + WS_BAR) + i, 0u, __ATOMIC_RELAXED, __HIP_MEMORY_SCOPE_AGENT);
#define GRID_BAR() xcd_barrier(xbar)
#define PHASE_IDS const int tid = opq(threadIdx.x), lane = tid & 63, wid = tid >> 6, gw = bid * (NT / 64) + wid; (void)lane; (void)gw; (void)wid;

  const float* x = p.in[0];
  const float *emb_g = p.in[1], *emb_b = p.in[2], *w_in = p.in[3], *rpb = p.in[4], *hg_lb = p.in[5], *hg_ng = p.in[6];
  const float *wpa = p.in[7], *wpb = p.in[8], *w_out = p.in[9], *ln1_g = p.in[10], *ln1_b = p.in[11];
  const float *w_rg = p.in[12], *b_rg = p.in[13], *w_re = p.in[14], *b_re = p.in[15];
  const float *w_gate = p.in[16], *w_up = p.in[17], *w_down = p.in[18], *ln2_g = p.in[19], *ln2_b = p.in[20];
  unsigned char* ws = p.ws;
  int* cnt = (int*)(ws + WS_CTRL); int* offs = (int*)(ws + WS_CTRL + 256); int* nmt_p = (int*)(ws + WS_CTRL + 512); int* tile_e = (int*)(ws + WS_CTRL + 1024);
  float* lb = (float*)(ws + WS_CTRL + 8192); int* blk_base = (int*)(ws + WS_CTRL + 32768);
  bf16_t* WT_in = (bf16_t*)(ws + WS_WT_IN); bf16_t* WT_pa = (bf16_t*)(ws + WS_WT_PA); bf16_t* WT_pb = (bf16_t*)(ws + WS_WT_PB); bf16_t* WT_out = (bf16_t*)(ws + WS_WT_OUT);
  bf16_t* WT_gu = (bf16_t*)(ws + WS_WT_GU); bf16_t* WT_d = (bf16_t*)(ws + WS_WT_D);
  bf16_t* hb = (bf16_t*)(ws + WS_HB); bf16_t* hid = (bf16_t*)(ws + WS_HID);
  bf16_t* a_na = (bf16_t*)((unsigned char*)p.out + 128 * MiB); bf16_t* c_hg = (bf16_t*)((unsigned char*)p.out + 192 * MiB);
  bf16_t* NAQ = (bf16_t*)(ws + WS_NAQ); bf16_t* NAK = (bf16_t*)(ws + WS_NAK); bf16_t* NAV = (bf16_t*)(ws + WS_NAV); bf16_t* HQ = (bf16_t*)(ws + WS_HQ);
  bf16_t* GF = (bf16_t*)(ws + WS_GF); bf16_t* GBW = (bf16_t*)(ws + WS_GB); bf16_t* HI = (bf16_t*)(ws + WS_HI); bf16_t* HG = (bf16_t*)(ws + WS_HG);
  bf16_t* GA = (bf16_t*)(ws + WS_GA); bf16_t* GBT = (bf16_t*)(ws + WS_GBT);
  int* srt = (int*)(ws + WS_XG);
  bf16_t* T1 = (bf16_t*)(ws + WS_T1); bf16_t* merged = (bf16_t*)(ws + WS_MERGED); bf16_t* h1b = (bf16_t*)(ws + WS_H1B); bf16_t* xg = (bf16_t*)(ws + WS_XG); bf16_t* ybuf = (bf16_t*)(ws + WS_Y);
  int* tok_e = (int*)(ws + WS_TOKE); int* tok_p = (int*)(ws + WS_TOKP); float* tok_w = (float*)(ws + WS_TOKW);
  float* Sloc = (float*)c_hg;
  float* Dtot = (float*)((unsigned char*)c_hg + 16 * MiB);
  bf16_t* obf = (bf16_t*)p.out; bf16_t* obb = (bf16_t*)p.out + (size_t)NTOK * HGW; float* h1 = p.out;

  { PHASE_IDS
    if (bid == 0 && tid < NE) cnt[tid] = 0;
    for (int i = bid * NT + tid; i < 2 * HGW; i += G * NT) {
      const int dir = i / HGW, c = i % HGW;
      const float v0 = hg_lb[dir * 2 * HGW + c], v1 = hg_lb[dir * 2 * HGW + HGW + c];
      const float m = fmaxf(v0, v1), e0 = expf(v0 - m), e1 = expf(v1 - m);
      lb[i] = e0 / (e0 + e1);
    }
    LAS float* scr = (LAS float*)(lds + wid * 16384);
    constexpr int I_IN = (D / 64) * (DIN / 32), I_PA = (NAW / 64) * (D / 32), I_OUT = (D / 64) * (D / 32), I_GU = (D / 64) * (DFF / 32), I_DN = (DFF / 64) * (D / 32);
    constexpr int NITEMS = I_IN + 2 * I_PA + I_OUT + NE * (2 * I_GU + I_DN);
    {
      const P0Ptrs PP{w_in, wpa, wpb, w_out, w_gate, w_up, w_down, WT_in, WT_pa, WT_pb, WT_out, WT_gu, WT_d};
      f32x4 gq4[4], bq4[4];
#pragma unroll
      for (int j = 0; j < 4; ++j) { gq4[j] = ((const f32x4*)emb_g)[lane + 64 * j]; bq4[j] = ((const f32x4*)emb_b)[lane + 64 * j]; }
      f32x4 xn[2][4], wn[8]; bf16_t* dstn = nullptr; int Kn_ = 0;
#define P0_LOADX(t_) do { const f32x4* xr_ = (const f32x4*)(x + (size_t)(t_) * D) + lane; \
        _Pragma("unroll") for (int rr = 0; rr < 2; ++rr) _Pragma("unroll") for (int j = 0; j < 4; ++j) xn[rr][j] = xr_[rr * (D / 4) + 64 * j]; } while (0)
#define P0_LOADW(it_) do { const float* src_; int N_; p0_decode(PP, (it_), src_, N_, dstn, Kn_); \
        _Pragma("unroll") for (int i = 0; i < 8; ++i) wn[i] = *(const f32x4*)(src_ + (size_t)((lane >> 3) + 8 * i) * N_ + (lane & 7) * 4); } while (0)
      constexpr int NSTEP = NTOK / 2 / 2048;
      P0_LOADX(2 * gw); if (gw < NITEMS) P0_LOADW(gw);
#pragma unroll 1
      for (int k = 0; k < NSTEP; ++k) {
        const int t = 2 * gw + k * 2 * NGW, it = gw + k * NGW;
        f32x4 v[2][4], wv[8]; bf16_t* dst = dstn; const int K_ = Kn_;
#pragma unroll
        for (int rr = 0; rr < 2; ++rr)
#pragma unroll
          for (int j = 0; j < 4; ++j) v[rr][j] = xn[rr][j];
#pragma unroll
        for (int i = 0; i < 8; ++i) wv[i] = wn[i];
        if (k + 1 < NSTEP) { P0_LOADX(t + 2 * NGW); if (it + NGW < NITEMS) P0_LOADW(it + NGW); }
        float s0 = 0.f, s1 = 0.f;
#pragma unroll
        for (int j = 0; j < 4; ++j) { s0 += (v[0][j].x + v[0][j].y) + (v[0][j].z + v[0][j].w); s1 += (v[1][j].x + v[1][j].y) + (v[1][j].z + v[1][j].w); }
        const float mean0 = wave_sum(s0) * (1.f / D), mean1 = wave_sum(s1) * (1.f / D);
        float q0 = 0.f, q1 = 0.f;
#pragma unroll
        for (int j = 0; j < 4; ++j) { v[0][j] = v[0][j] - mean0; v[1][j] = v[1][j] - mean1;
          q0 += (v[0][j].x * v[0][j].x + v[0][j].y * v[0][j].y) + (v[0][j].z * v[0][j].z + v[0][j].w * v[0][j].w);
          q1 += (v[1][j].x * v[1][j].x + v[1][j].y * v[1][j].y) + (v[1][j].z * v[1][j].z + v[1][j].w * v[1][j].w); }
        const float rstd0 = rsqrtf(wave_sum(q0) * (1.f / D) + LN_EPS), rstd1 = rsqrtf(wave_sum(q1) * (1.f / D) + LN_EPS);
        u32x2* o8 = (u32x2*)(hb + (size_t)t * D) + lane;
#pragma unroll
        for (int j = 0; j < 4; ++j) {
          const f32x4 oa = v[0][j] * rstd0 * gq4[j] + bq4[j], ob_ = v[1][j] * rstd1 * gq4[j] + bq4[j];
          u32x2 wa; wa.x = cvt_pk_bf16(oa.x, oa.y); wa.y = cvt_pk_bf16(oa.z, oa.w); o8[64 * j] = wa;
          u32x2 wb; wb.x = cvt_pk_bf16(ob_.x, ob_.y); wb.y = cvt_pk_bf16(ob_.z, ob_.w); o8[D / 4 + 64 * j] = wb;
        }
        if (it < NITEMS) {
#pragma unroll
          for (int i = 0; i < 8; ++i) { LAS float* d = scr + ((lane >> 3) + 8 * i) * 33 + (lane & 7) * 4; d[0] = wv[i].x; d[1] = wv[i].y; d[2] = wv[i].z; d[3] = wv[i].w; }
          asm volatile("s_waitcnt lgkmcnt(0)" ::: "memory");
          const int c = lane & 7;
#pragma unroll
          for (int j = 0; j < 4; ++j) { const int n = (lane >> 3) + 8 * j; const LAS float* sp = scr + (8 * c) * 33 + n;
            u32x4 o; o.x = cvt_pk_bf16(sp[0 * 33], sp[1 * 33]); o.y = cvt_pk_bf16(sp[2 * 33], sp[3 * 33]); o.z = cvt_pk_bf16(sp[4 * 33], sp[5 * 33]); o.w = cvt_pk_bf16(sp[6 * 33], sp[7 * 33]);
            *(u32x4*)(dst + (size_t)n * K_ + 8 * c) = o; }
          asm volatile("s_waitcnt lgkmcnt(0)" ::: "memory");
        }
      }
#undef P0_LOADX
#undef P0_LOADW
    }
  }
  grid.sync();
  XcdBarrier xbar = xcd_barrier_post((unsigned*)(p.ws + WS_BAR), bst);
  {
    pg8::Gemm g{hb, WT_in, D, 0}; pg8::StaticOrder S; S.init(NTOK, DIN, G, bid);
    { LAS float* lbl = (LAS float*)(lds + 131072 + 4096); for (int i = threadIdx.x; i < 2 * HGW; i += NT) lbl[i] = lb[i]; __syncthreads(); }
    pg8::EpiU E{ws + WS_U0, lds + 131072 + 8192, (const LAS float*)(lds + 131072 + 4096)};
    pg8::gemm_phase(lds, g, S, E);
  }
  GRID_BAR();
  { PHASE_IDS
    const int w = __builtin_amdgcn_readfirstlane(wid);
    const int seq = bid >> 2, sg = bid & 3, b = seq >> 3, dir = (seq >> 2) & 1, head = seq & 3;
    const bf16_t* Gp = dir ? GBW : GF; bf16_t* ob = dir ? obb : obf;
    const size_t t0 = (size_t)b * SEQ;
    const int hh = lane >> 5, r = lane & 31;
    constexpr float LOG2E = 1.4426950408889634f;
    for (int i = tid; i < 128 * 272 / 4; i += NT) ((LAS unsigned*)(lds + SC_ST))[i] = 0u;
    f32x16 s0, s1, oacc;
#pragma unroll
    for (int i = 0; i < 16; ++i) { s0[i] = 0.f; s1[i] = 0.f; }
    const int kbS = w >> 1, vbS = 2 * (w & 1), ibO = w >> 2, vbO = w & 3;
    float bsum0 = 0.f, bsum1 = 0.f;
    unsigned gq[8], gg[8]; u32x4 gv0, gv1;
    const int vrow = tid >> 2, vpart = tid & 3;
    const int coff = head * HGD + 2 * lane;
    const bf16_t* VTg = HI + (size_t)((b * 4 + head) * 128) * 128 * 64;
#define SC_TOK(c_, i_) (dir ? (SEQ - 1 - ((c_) * 64 + (i_))) : ((c_) * 64 + (i_)))
#define SC_LOAD(c_, Q_, G_, V0_, V1_) do { const size_t tb_ = (t0 + SC_TOK(c_, 8 * w)) * HGW + coff; const bf16_t* qb_ = HQ + tb_; const bf16_t* gb_ = Gp + tb_; \
      if (dir) { _Pragma("unroll") for (int e = 0; e < 8; ++e) { Q_[e] = *(const unsigned*)(qb_ - e * HGW); G_[e] = *(const unsigned*)(gb_ - e * HGW); } } \
      else { _Pragma("unroll") for (int e = 0; e < 8; ++e) { Q_[e] = *(const unsigned*)(qb_ + e * HGW); G_[e] = *(const unsigned*)(gb_ + e * HGW); } } \
      { const bf16_t* vp_ = VTg + ((size_t)((dir ? 127 - (c_) : (c_)) * 128 + vrow)) * 64 + vpart * 16; V0_ = *(const u32x4*)vp_; V1_ = *(const u32x4*)(vp_ + 8); } } while (0)
    unsigned gqB[8], ggB[8]; u32x4 gv0B, gv1B;
    SC_LOAD(32 * sg, gq, gg, gv0, gv1); SC_LOAD(32 * sg + 1, gqB, ggB, gv0B, gv1B);
    auto sc_chunk = [&](const int c, unsigned (&Q_)[8], unsigned (&G_)[8], u32x4& V0_, u32x4& V1_) __attribute__((always_inline)) {
      const int cg_ = 32 * sg + c;
      float c0[8], c1[8], l0[8], l1[8];
      {
        float a0 = 0.f, a1 = 0.f;
#pragma unroll
        for (int e = 0; e < 8; ++e) {
          l0[e] = h2f((unsigned short)(G_[e] & 0xffffu)) * LOG2E; l1[e] = h2f((unsigned short)(G_[e] >> 16)) * LOG2E;
          a0 += l0[e]; a1 += l1[e]; c0[e] = a0; c1[e] = a1;
        }
        *(LAS f32x2*)(lds + SC_TOT + (w * 128 + 2 * lane) * 4) = (f32x2){a0, a1};
      }
      __syncthreads();
      float off0 = 0.f, off1 = 0.f, bl0 = 0.f, bl1 = 0.f;
#pragma unroll
      for (int w2 = 0; w2 < 8; ++w2) {
        const f32x2 tv = *(const LAS f32x2*)(lds + SC_TOT + (w2 * 128 + 2 * lane) * 4);
        bl0 += tv.x; bl1 += tv.y; if (w2 < w) { off0 += tv.x; off1 += tv.y; }
      }
      bsum0 += bl0; bsum1 += bl1;
      const float eb0 = __builtin_amdgcn_exp2f(bl0), eb1 = __builtin_amdgcn_exp2f(bl1);
      if (w == 0) *(LAS f32x2*)(lds + SC_EB + 2 * lane * 4) = (f32x2){eb0, eb1};
      {
        float kp0[8], kp1[8];
#pragma unroll
        for (int e = 0; e < 8; ++e) {
          const float B0 = off0 + c0[e], B1 = off1 + c1[e];
          const float q0 = __uint_as_float(Q_[e] << 16), q1 = __uint_as_float(Q_[e] & 0xffff0000u);
          const float k0 = 1.f - __builtin_amdgcn_exp2f(l0[e]), k1 = 1.f - __builtin_amdgcn_exp2f(l1[e]);
          const float e0 = __builtin_amdgcn_exp2f(B0), e1 = __builtin_amdgcn_exp2f(B1);
          const float qp0 = q0 * e0, qp1 = q1 * e1;
          const float kq0 = k0 * __builtin_amdgcn_rcpf(e0), kq1 = k1 * __builtin_amdgcn_rcpf(e1);
          kp0[e] = kq0 * eb0; kp1[e] = kq1 * eb1;
          const int i = 8 * w + e;
          *(LAS unsigned*)(lds + SC_QP + i * 272 + lane * 4) = cvt_pk_bf16(qp0, qp1);
          *(LAS unsigned*)(lds + SC_KP + i * 272 + lane * 4) = cvt_pk_bf16(kq0, kq1);
        }
        const int kto = dir ? (56 - 8 * w) * 2 : 16 * w;
        u32x4 t;
        if (dir) { t.x = cvt_pk_bf16(kp0[7], kp0[6]); t.y = cvt_pk_bf16(kp0[5], kp0[4]); t.z = cvt_pk_bf16(kp0[3], kp0[2]); t.w = cvt_pk_bf16(kp0[1], kp0[0]); }
        else { t.x = cvt_pk_bf16(kp0[0], kp0[1]); t.y = cvt_pk_bf16(kp0[2], kp0[3]); t.z = cvt_pk_bf16(kp0[4], kp0[5]); t.w = cvt_pk_bf16(kp0[6], kp0[7]); }
        *(LAS u32x4*)(lds + SC_KT + (2 * lane) * 144 + kto) = t;
        if (dir) { t.x = cvt_pk_bf16(kp1[7], kp1[6]); t.y = cvt_pk_bf16(kp1[5], kp1[4]); t.z = cvt_pk_bf16(kp1[3], kp1[2]); t.w = cvt_pk_bf16(kp1[1], kp1[0]); }
        else { t.x = cvt_pk_bf16(kp1[0], kp1[1]); t.y = cvt_pk_bf16(kp1[2], kp1[3]); t.z = cvt_pk_bf16(kp1[4], kp1[5]); t.w = cvt_pk_bf16(kp1[6], kp1[7]); }
        *(LAS u32x4*)(lds + SC_KT + (2 * lane + 1) * 144 + kto) = t;
        *(LAS u32x4*)(lds + SC_VT + vrow * 144 + vpart * 32) = V0_;
        *(LAS u32x4*)(lds + SC_VT + vrow * 144 + vpart * 32 + 16) = V1_;
      }
      __syncthreads();
      { const int c2_ = (c + 2 < 32) ? cg_ + 2 : cg_; SC_LOAD(c2_, Q_, G_, V0_, V1_); }
      {
#pragma unroll
        for (int g = 0; g < 4; ++g) { const f32x4 eb = *(const LAS f32x4*)(lds + SC_EB + (kbS * 32 + 8 * g + 4 * hh) * 4);
          s0[4 * g] *= eb[0]; s0[4 * g + 1] *= eb[1]; s0[4 * g + 2] *= eb[2]; s0[4 * g + 3] *= eb[3];
          s1[4 * g] *= eb[0]; s1[4 * g + 1] *= eb[1]; s1[4 * g + 2] *= eb[2]; s1[4 * g + 3] *= eb[3]; }
        bf16x8 fk[4], fv0[4], fv1[4];
#pragma unroll
        for (int st = 0; st < 4; ++st) { fk[st] = ldfrag(lds + SC_KT, 144, kbS * 32 + r, 8 * hh + 16 * st); fv0[st] = ldfrag(lds + SC_VT, 144, vbS * 32 + r, 8 * hh + 16 * st); fv1[st] = ldfrag(lds + SC_VT, 144, vbS * 32 + 32 + r, 8 * hh + 16 * st); }
        __builtin_amdgcn_sched_barrier(0);
#pragma unroll
        for (int st = 0; st < 4; ++st) { s0 = MFMA32(fk[st], fv0[st], s0); s1 = MFMA32(fk[st], fv1[st], s1); }
      }
      if (w >= 5) {
        const int jb = (w == 7), ib = (w >= 6);
        f32x16 x;
#pragma unroll
        for (int i = 0; i < 16; ++i) x[i] = 0.f;
        { bf16x8 fa[8], fb[8];
#pragma unroll
          for (int st = 0; st < 8; ++st) { fa[st] = ldfrag(lds + SC_KP, 272, jb * 32 + r, 8 * hh + 16 * st); fb[st] = ldfrag(lds + SC_QP, 272, ib * 32 + r, 8 * hh + 16 * st); }
          __builtin_amdgcn_sched_barrier(0);
#pragma unroll
          for (int st = 0; st < 8; ++st) x = MFMA32(fa[st], fb[st], x); }
        const int ii = ib * 32 + r;
#pragma unroll
        for (int g = 0; g < 4; ++g) {
          const int j0 = jb * 32 + 8 * g + 4 * hh;
          const float x0 = (j0 + 0 <= ii) ? x[4 * g] : 0.f, x1 = (j0 + 1 <= ii) ? x[4 * g + 1] : 0.f, x2 = (j0 + 2 <= ii) ? x[4 * g + 2] : 0.f, x3 = (j0 + 3 <= ii) ? x[4 * g + 3] : 0.f;
          u32x2 pk;
          if (dir) { pk.x = cvt_pk_bf16(x3, x2); pk.y = cvt_pk_bf16(x1, x0); *(LAS u32x2*)(lds + SC_A + ii * 144 + (60 - j0) * 2) = pk; }
          else { pk.x = cvt_pk_bf16(x0, x1); pk.y = cvt_pk_bf16(x2, x3); *(LAS u32x2*)(lds + SC_A + ii * 144 + j0 * 2) = pk; }
        }
      }
      {
#pragma unroll
        for (int i = 0; i < 16; ++i) oacc[i] = 0.f;
        bf16x8 fa[8], fb[8];
#pragma unroll
        for (int st = 0; st < 8; ++st) { fa[st] = ldfrag(lds + SC_QP, 272, ibO * 32 + r, 8 * hh + 16 * st); fb[st] = ldfrag(lds + SC_ST, 272, vbO * 32 + r, 8 * hh + 16 * st); }
        __builtin_amdgcn_sched_barrier(0);
#pragma unroll
        for (int st = 0; st < 8; ++st) oacc = MFMA32(fa[st], fb[st], oacc);
      }
      __syncthreads();
      {
        const int st0 = (ibO == 0 && dir) ? 2 : 0, st1 = (ibO == 0 && !dir) ? 2 : 4;
        { bf16x8 fa[4], fb[4];
#pragma unroll
          for (int st = 0; st < 4; ++st) { fa[st] = ldfrag(lds + SC_A, 144, ibO * 32 + r, 8 * hh + 16 * st); fb[st] = ldfrag(lds + SC_VT, 144, vbO * 32 + r, 8 * hh + 16 * st); }
          __builtin_amdgcn_sched_barrier(0);
#pragma unroll
          for (int st = 0; st < 4; ++st) if (st >= st0 && st < st1) oacc = MFMA32(fa[st], fb[st], oacc); }
        {
          bf16_t* ob0 = ob + (t0 + SC_TOK(cg_, ibO * 32 + 4 * hh)) * HGW + head * HGD + vbO * 32 + r;
          if (dir) {
#pragma unroll
            for (int rg = 0; rg < 16; ++rg) ob0[-((rg & 3) + 8 * (rg >> 2)) * HGW] = __builtin_bit_cast(unsigned short, (__bf16)oacc[rg]);
          } else {
#pragma unroll
            for (int rg = 0; rg < 16; ++rg) ob0[((rg & 3) + 8 * (rg >> 2)) * HGW] = __builtin_bit_cast(unsigned short, (__bf16)oacc[rg]);
          }
        }
#pragma unroll
        for (int g = 0; g < 4; ++g) {
          u32x2 pk; pk.x = cvt_pk_bf16(s0[4 * g], s0[4 * g + 1]); pk.y = cvt_pk_bf16(s0[4 * g + 2], s0[4 * g + 3]);
          *(LAS u32x2*)(lds + SC_ST + (vbS * 32 + r) * 272 + (kbS * 32 + 8 * g + 4 * hh) * 2) = pk;
          pk.x = cvt_pk_bf16(s1[4 * g], s1[4 * g + 1]); pk.y = cvt_pk_bf16(s1[4 * g + 2], s1[4 * g + 3]);
          *(LAS u32x2*)(lds + SC_ST + (vbS * 32 + 32 + r) * 272 + (kbS * 32 + 8 * g + 4 * hh) * 2) = pk;
        }
      }
      __syncthreads();
    };
    for (int c = 0; c < 32; c += 2) { sc_chunk(c, gq, gg, gv0, gv1); sc_chunk(c + 1, gqB, ggB, gv0B, gv1B); }
    {
      float* sl = Sloc + (size_t)(seq * 4 + sg) * 128 * 128;
#pragma unroll
      for (int rg = 0; rg < 16; ++rg) { const int k = kbS * 32 + (rg & 3) + 8 * (rg >> 2) + 4 * hh;
        sl[k * 128 + vbS * 32 + r] = s0[rg]; sl[k * 128 + vbS * 32 + 32 + r] = s1[rg]; }
      if (w == 0) *(f32x2*)(Dtot + (size_t)(seq * 4 + sg) * 128 + 2 * lane) = (f32x2){bsum0, bsum1};
    }
  }
  { PHASE_IDS
    constexpr float LOG2E = 1.4426950408889634f;
    constexpr int NA_TB = 131072;
    const int bh = (bid & 7) * 8 + (bid >> 5), b = bh >> 3, head = bh & 7, rq = (bid >> 3) & 3;
    LAS float* Tb = (LAS float*)(lds + NA_TB);
    for (int idx = tid; idx < 15 * 128; idx += NT) { const int dr = idx >> 7, xx = (idx & 127) - 48; Tb[idx] = (xx >= 0 && xx <= 30) ? rpb[(head * 15 + dr) * 31 + xx] * LOG2E : 0.f; }
    const int w = __builtin_amdgcn_readfirstlane(wid), qb = w & 1, hh = lane >> 5, ql = lane & 31, c = 32 * qb + ql;
    int cs = c - KW / 2; cs = cs < 0 ? 0 : (cs > GW - KW ? GW - KW : cs);
    float cm[3][2][4];
#pragma unroll
    for (int cbi = 0; cbi < 3; ++cbi)
#pragma unroll
      for (int g1 = 0; g1 < 2; ++g1)
#pragma unroll
        for (int jj = 0; jj < 4; ++jj) { const int kc = 16 * (qb + cbi) + 8 * hh + 4 * g1 + jj; cm[cbi][g1][jj] = (kc >= cs && kc < cs + KW) ? 0.f : -1.0e30f; }
    const int lbase = NA_TB + ((63 - c) + 8 * hh + 16 * qb) * 4;
    const int colperm = 8 * ((ql >> 2) & 1) + 4 * ((ql >> 3) & 1) + (ql & 3);
    const int koff = (hh * 64 + 16 * qb + colperm) * 16;
    const int voff = 8192 + ((2 * qb + hh) * 64 + ql) * 16;
    const bf16_t* Krows = NAK + (size_t)((b * 8 + head) * 128) * 4096 + tid * 8;
    const bf16_t* Vrows = NAV + (size_t)((b * 8 + head) * 128) * 4096 + tid * 8;
#define NA_RS(r_) ((r_) - KH / 2 < 0 ? 0 : ((r_) - KH / 2 > ROWS - KH ? ROWS - KH : (r_) - KH / 2))
    bf16x8 Qn[4];
#define NA_QLD(u_) do { const size_t tq_ = (size_t)b * SEQ + (32 * rq + 4 * (u_) + (w >> 1)) * GW + c; \
      _Pragma("unroll") for (int st = 0; st < 4; ++st) Qn[st] = *(const bf16x8*)(NAQ + tq_ * NAW + head * NADH + 16 * st + 8 * hh); } while (0)
    NA_QLD(0);
    {
      const int rlo = NA_RS(32 * rq), rhi = NA_RS(32 * rq + 31) + 7;
      unsigned acc_t = 0u;
      for (int i = tid; i < (rhi - rlo + 1) * 2; i += NT) {
        acc_t += *(const unsigned*)(NAK + (size_t)((b * 8 + head) * 128 + rlo) * 4096 + (size_t)i * 2048);
        acc_t += *(const unsigned*)(NAV + (size_t)((b * 8 + head) * 128 + rlo) * 4096 + (size_t)i * 2048);
      }
      for (int i = tid; i < 32 * 64 / 4; i += NT) {
        const size_t tk = (size_t)b * SEQ + (32 * rq) * GW + 4 * i;
        acc_t += *(const unsigned*)(NAQ + tk * NAW + head * NADH);
        acc_t += *(const unsigned*)(a_na + tk * NAW + head * NADH);
      }
      asm volatile("" :: "v"(acc_t));
    }
    int hi;
    {
      const int r0 = 32 * rq; const int lo = NA_RS(r0); hi = NA_RS(r0 + 3) + 1;
      u32x4 kv[5], vv[5];
#pragma unroll
      for (int k = 0; k < 5; ++k) { const int row = (lo + k <= hi) ? lo + k : hi; kv[k] = *(const u32x4*)(Krows + (size_t)row * 4096); vv[k] = *(const u32x4*)(Vrows + (size_t)row * 4096); }
#pragma unroll
      for (int k = 0; k < 5; ++k) { const int row = (lo + k <= hi) ? lo + k : hi;
        *(LAS u32x4*)(lds + (row & 7) * 16384 + tid * 16) = kv[k]; *(LAS u32x4*)(lds + (row & 7) * 16384 + 8192 + tid * 16) = vv[k]; }
    }
#define NA_NEED(k_) ((k_) >= 32 ? ROWS - 1 : (NA_RS(32 * rq + 4 * ((k_) >> 2) + 3) + 2 * ((k_) & 3) + 1 > ROWS - 1 ? ROWS - 1 : NA_RS(32 * rq + 4 * ((k_) >> 2) + 3) + 2 * ((k_) & 3) + 1))
    u32x4 pkO0, pvO0, pkO1, pvO1; int nO;
    { int t1 = NA_NEED(1); t1 = t1 < hi ? hi : t1; nO = t1 - hi;
      if (nO >= 1) { pkO0 = *(const u32x4*)(Krows + (size_t)(hi + 1) * 4096); pvO0 = *(const u32x4*)(Vrows + (size_t)(hi + 1) * 4096); }
      if (nO >= 2) { pkO1 = *(const u32x4*)(Krows + (size_t)(hi + 2) * 4096); pvO1 = *(const u32x4*)(Vrows + (size_t)(hi + 2) * 4096); } }
#pragma unroll 1
    for (int u = 0; u < 8; ++u) {
      const int r0u = 32 * rq + 4 * u, r = r0u + (w >> 1);
      const int rs = NA_RS(r), dr0 = rs - r + 7;
      const size_t tokQ = (size_t)b * SEQ + r * GW + c;
      bf16x8 Qf[4];
#pragma unroll
      for (int st = 0; st < 4; ++st) Qf[st] = Qn[st];
      asm volatile("" : "+v"(Qf[0]), "+v"(Qf[1]), "+v"(Qf[2]), "+v"(Qf[3]));
      NA_QLD(u < 7 ? u + 1 : u);
      float mx = -1.0e30f, lsum = 0.f; f32x16 o0, o1;
#pragma unroll
      for (int i = 0; i < 16; ++i) { o0[i] = 0.f; o1[i] = 0.f; }
#pragma unroll 1
      for (int i2 = 0; i2 < 4; ++i2) {
        __syncthreads();
        const int kstep_ = 4 * u + i2, req = hi + nO;
        int tgt = (kstep_ + 2 < 32) ? NA_NEED(kstep_ + 2) : req; tgt = tgt < req ? req : tgt;
        const int nN = tgt - req;
        u32x4 pkN0, pvN0, pkN1, pvN1;
        if (nN >= 1) { pkN0 = *(const u32x4*)(Krows + (size_t)(req + 1) * 4096); pvN0 = *(const u32x4*)(Vrows + (size_t)(req + 1) * 4096); }
        if (nN >= 2) { pkN1 = *(const u32x4*)(Krows + (size_t)(req + 2) * 4096); pvN1 = *(const u32x4*)(Vrows + (size_t)(req + 2) * 4096); }
        const int tbo = lbase + (dr0 + 2 * i2) * 512;
        const int kslot = ((rs + 2 * i2 + (ql >> 4)) & 7) * 16384 + koff;
        const int vslot0 = ((rs + 2 * i2) & 7) * 16384 + voff, vslot1 = ((rs + 2 * i2 + 1) & 7) * 16384 + voff;
#pragma unroll
        for (int cbi = 0; cbi < 3; ++cbi) {
          f32x16 acc;
#pragma unroll
          for (int rg = 0; rg < 16; ++rg) { const int gg = rg >> 2, jj = rg & 3;
            acc[rg] = *(const LAS float*)(lds + tbo + (gg >> 1) * 512 + (16 * cbi + 4 * (gg & 1) + jj) * 4) + cm[cbi][gg & 1][jj]; }
          {
            bf16x8 kf[4];
#pragma unroll
            for (int st = 0; st < 4; ++st) kf[st] = *(const LAS bf16x8*)(lds + kslot + (2 * st * 64 + 16 * cbi) * 16);
            __builtin_amdgcn_sched_barrier(0);
#pragma unroll
            for (int st = 0; st < 4; ++st) acc = MFMA32(kf[st], Qf[st], acc);
          }
          bf16x8 vf[4];
          vf[0] = *(const LAS bf16x8*)(lds + vslot0 + (2 * cbi * 64) * 16); vf[1] = *(const LAS bf16x8*)(lds + vslot0 + (2 * cbi * 64 + 32) * 16);
          vf[2] = *(const LAS bf16x8*)(lds + vslot1 + (2 * cbi * 64) * 16); vf[3] = *(const LAS bf16x8*)(lds + vslot1 + (2 * cbi * 64 + 32) * 16);
          float tm = fmaxf(fmaxf(fmaxf(acc[0], acc[1]), fmaxf(acc[2], acc[3])), fmaxf(fmaxf(acc[4], acc[5]), fmaxf(acc[6], acc[7])));
          tm = fmaxf(tm, fmaxf(fmaxf(fmaxf(acc[8], acc[9]), fmaxf(acc[10], acc[11])), fmaxf(fmaxf(acc[12], acc[13]), fmaxf(acc[14], acc[15]))));
          tm = half_swap_max(tm);
          const float mn = fmaxf(mx, tm), alpha = __builtin_amdgcn_exp2f(mx - mn);
          mx = mn;
          bf16x8 Pf[2]; float ts = 0.f;
#pragma unroll
          for (int st = 0; st < 2; ++st) {
            float pv[8];
#pragma unroll
            for (int j = 0; j < 8; ++j) { pv[j] = __builtin_amdgcn_exp2f(acc[8 * st + j] - mn); ts += pv[j]; }
            u32x4 pk; pk.x = cvt_pk_bf16(pv[0], pv[1]); pk.y = cvt_pk_bf16(pv[2], pv[3]); pk.z = cvt_pk_bf16(pv[4], pv[5]); pk.w = cvt_pk_bf16(pv[6], pv[7]);
            Pf[st] = __builtin_bit_cast(bf16x8, pk);
          }
          lsum = lsum * alpha + ts;
#pragma unroll
          for (int i = 0; i < 16; ++i) { o0[i] *= alpha; o1[i] *= alpha; }
          o0 = MFMA32(vf[0], Pf[0], o0);
          o1 = MFMA32(vf[1], Pf[0], o1);
          o0 = MFMA32(vf[2], Pf[1], o0);
          o1 = MFMA32(vf[3], Pf[1], o1);
        }
        if (nO >= 1) { *(LAS u32x4*)(lds + ((hi + 1) & 7) * 16384 + tid * 16) = pkO0; *(LAS u32x4*)(lds + ((hi + 1) & 7) * 16384 + 8192 + tid * 16) = pvO0; }
        if (nO >= 2) { *(LAS u32x4*)(lds + ((hi + 2) & 7) * 16384 + tid * 16) = pkO1; *(LAS u32x4*)(lds + ((hi + 2) & 7) * 16384 + 8192 + tid * 16) = pvO1; }
        hi = req; nO = nN; pkO0 = pkN0; pvO0 = pvN0; pkO1 = pkN1; pvO1 = pvN1;
      }
      lsum = half_swap_sum(lsum);
      const float inv = 1.f / lsum;
      bf16_t* op = a_na + tokQ * NAW + head * NADH + 4 * hh;
#pragma unroll
      for (int g = 0; g < 4; ++g) {
        u32x2 pk; pk.x = cvt_pk_bf16(o0[4 * g] * inv, o0[4 * g + 1] * inv); pk.y = cvt_pk_bf16(o0[4 * g + 2] * inv, o0[4 * g + 3] * inv);
        *(u32x2*)(op + 8 * g) = pk;
        pk.x = cvt_pk_bf16(o1[4 * g] * inv, o1[4 * g + 1] * inv); pk.y = cvt_pk_bf16(o1[4 * g + 2] * inv, o1[4 * g + 3] * inv);
        *(u32x2*)(op + 32 + 8 * g) = pk;
      }
    }
  }
#undef NA_NEED
#undef NA_RS
#undef NA_QLD
  GRID_BAR();
  { PHASE_IDS
    const int w = __builtin_amdgcn_readfirstlane(wid);
    const int seq = bid >> 2, sg = bid & 3, b = seq >> 3, dir = (seq >> 2) & 1, head = seq & 3;
    if (sg > 0) {
      const bf16_t* Gp = dir ? GBW : GF; bf16_t* ob = dir ? obb : obf;
      const size_t t0 = (size_t)b * SEQ;
      const int hh = lane >> 5, r = lane & 31;
      constexpr float LOG2E = 1.4426950408889634f;
      const int kbS = w >> 1, vbS = 2 * (w & 1), ibO = w >> 2, vbO = w & 3;
      {
        f32x16 s0, s1;
#pragma unroll
        for (int i = 0; i < 16; ++i) { s0[i] = 0.f; s1[i] = 0.f; }
        for (int q = 0; q < sg; ++q) {
          const float* sl = Sloc + (size_t)(seq * 4 + q) * 128 * 128; const float* dt = Dtot + (size_t)(seq * 4 + q) * 128;
#pragma unroll
          for (int rg = 0; rg < 16; ++rg) { const int k = kbS * 32 + (rg & 3) + 8 * (rg >> 2) + 4 * hh; const float dk = __builtin_amdgcn_exp2f(dt[k]);
            s0[rg] = s0[rg] * dk + sl[k * 128 + vbS * 32 + r]; s1[rg] = s1[rg] * dk + sl[k * 128 + vbS * 32 + 32 + r]; }
        }
#pragma unroll
        for (int g = 0; g < 4; ++g) {
          u32x2 pk; pk.x = cvt_pk_bf16(s0[4 * g], s0[4 * g + 1]); pk.y = cvt_pk_bf16(s0[4 * g + 2], s0[4 * g + 3]);
          *(LAS u32x2*)(lds + SC_ST + (vbS * 32 + r) * 272 + (kbS * 32 + 8 * g + 4 * hh) * 2) = pk;
          pk.x = cvt_pk_bf16(s1[4 * g], s1[4 * g + 1]); pk.y = cvt_pk_bf16(s1[4 * g + 2], s1[4 * g + 3]);
          *(LAS u32x2*)(lds + SC_ST + (vbS * 32 + 32 + r) * 272 + (kbS * 32 + 8 * g + 4 * hh) * 2) = pk;
        }
      }
      const int coff = head * HGD + 2 * lane;
      float bp0 = 0.f, bp1 = 0.f;
      unsigned gq[8], gg[8], gqn[8], ggn[8];
#define P2S_LOAD(c_, Q_, G_) do { _Pragma("unroll") for (int e = 0; e < 8; ++e) { const size_t tk = t0 + SC_TOK(32 * sg + (c_), 8 * w + e); Q_[e] = *(const unsigned*)(HQ + tk * HGW + coff); G_[e] = *(const unsigned*)(Gp + tk * HGW + coff); } } while (0)
      P2S_LOAD(0, gq, gg);
      for (int c = 0; c < 32; ++c) {
        if (!__any(bp0 > -160.f || bp1 > -160.f)) break;
        const int cg_ = 32 * sg + c;
        P2S_LOAD(c + 1 < 32 ? c + 1 : c, gqn, ggn);
        float c0[8], c1[8];
        { float a0 = 0.f, a1 = 0.f;
#pragma unroll
          for (int e = 0; e < 8; ++e) { a0 += h2f((unsigned short)(gg[e] & 0xffffu)) * LOG2E; a1 += h2f((unsigned short)(gg[e] >> 16)) * LOG2E; c0[e] = a0; c1[e] = a1; }
          *(LAS f32x2*)(lds + SC_TOT + (w * 128 + 2 * lane) * 4) = (f32x2){a0, a1}; }
        __syncthreads();
        float off0 = bp0, off1 = bp1, bl0 = 0.f, bl1 = 0.f;
#pragma unroll
        for (int w2 = 0; w2 < 8; ++w2) { const f32x2 tv = *(const LAS f32x2*)(lds + SC_TOT + (w2 * 128 + 2 * lane) * 4);
          bl0 += tv.x; bl1 += tv.y; if (w2 < w) { off0 += tv.x; off1 += tv.y; } }
        bp0 += bl0; bp1 += bl1;
#pragma unroll
        for (int e = 0; e < 8; ++e) {
          const float q0 = __uint_as_float(gq[e] << 16), q1 = __uint_as_float(gq[e] & 0xffff0000u);
          *(LAS unsigned*)(lds + SC_QP + (8 * w + e) * 272 + lane * 4) = cvt_pk_bf16(q0 * __builtin_amdgcn_exp2f(off0 + c0[e]), q1 * __builtin_amdgcn_exp2f(off1 + c1[e]));
        }
        __syncthreads();
        f32x16 oacc;
#pragma unroll
        for (int i = 0; i < 16; ++i) oacc[i] = 0.f;
        { bf16x8 fa[8], fb[8];
#pragma unroll
          for (int st = 0; st < 8; ++st) { fa[st] = ldfrag(lds + SC_QP, 272, ibO * 32 + r, 8 * hh + 16 * st); fb[st] = ldfrag(lds + SC_ST, 272, vbO * 32 + r, 8 * hh + 16 * st); }
          __builtin_amdgcn_sched_barrier(0);
#pragma unroll
          for (int st = 0; st < 8; ++st) oacc = MFMA32(fa[st], fb[st], oacc); }
        {
          unsigned short ov[16];
#pragma unroll
          for (int rg = 0; rg < 16; ++rg) { const int i = ibO * 32 + (rg & 3) + 8 * (rg >> 2) + 4 * hh; ov[rg] = ob[(t0 + SC_TOK(cg_, i)) * HGW + head * HGD + vbO * 32 + r]; }
          asm volatile("" : "+v"(ov[0]), "+v"(ov[1]), "+v"(ov[2]), "+v"(ov[3]), "+v"(ov[4]), "+v"(ov[5]), "+v"(ov[6]), "+v"(ov[7]));
          asm volatile("" : "+v"(ov[8]), "+v"(ov[9]), "+v"(ov[10]), "+v"(ov[11]), "+v"(ov[12]), "+v"(ov[13]), "+v"(ov[14]), "+v"(ov[15]));
#pragma unroll
          for (int rg = 0; rg < 16; ++rg) { const int i = ibO * 32 + (rg & 3) + 8 * (rg >> 2) + 4 * hh;
            ob[(t0 + SC_TOK(cg_, i)) * HGW + head * HGD + vbO * 32 + r] = __builtin_bit_cast(unsigned short, (__bf16)(bf2f(ov[rg]) + oacc[rg])); }
        }
        __syncthreads();
#pragma unroll
        for (int e = 0; e < 8; ++e) { gq[e] = gqn[e]; gg[e] = ggn[e]; }
      }
#undef P2S_LOAD
    }
  }
#undef SC_TOK
#undef SC_LOAD
  GRID_BAR();
  { PHASE_IDS
    f32x4 ng0 = *(const f32x4*)(hg_ng + lane * 8), ng1 = *(const f32x4*)(hg_ng + lane * 8 + 4);
    u32x4 fan[2], fbn[2], ggn[2];
#define P2B_LOAD(t_) do { _Pragma("unroll") for (int q = 0; q < 2; ++q) { const size_t o0 = (size_t)((t_) + q) * HGW + lane * 8; \
      fan[q] = *(const u32x4*)(obf + o0); fbn[q] = *(const u32x4*)(obb + o0); ggn[q] = *(const u32x4*)(HG + o0); } } while (0)
    P2B_LOAD(2 * gw);
#pragma unroll 1
    for (int t = 2 * gw; t < NTOK; t += 2 * NGW) {
      u32x4 fa[2], fb[2], gg2[2];
#pragma unroll
      for (int q = 0; q < 2; ++q) { fa[q] = fan[q]; fb[q] = fbn[q]; gg2[q] = ggn[q]; }
      if (t + 2 * NGW < NTOK) P2B_LOAD(t + 2 * NGW);
#pragma unroll
      for (int q = 0; q < 2; ++q) {
        float a[8]; float ss = 0.f;
#pragma unroll
        for (int e = 0; e < 4; ++e) {
          a[2 * e] = __uint_as_float(fa[q][e] << 16) + __uint_as_float(fb[q][e] << 16);
          a[2 * e + 1] = __uint_as_float(fa[q][e] & 0xffff0000u) + __uint_as_float(fb[q][e] & 0xffff0000u);
          ss += a[2 * e] * a[2 * e] + a[2 * e + 1] * a[2 * e + 1];
        }
        ss = row_sum16(ss);
        const float rs = rsqrtf(ss * (1.f / HGD) + RMS_EPS);
        const float ngv[8] = {ng0.x, ng0.y, ng0.z, ng0.w, ng1.x, ng1.y, ng1.z, ng1.w};
        float o[8];
#pragma unroll
        for (int e = 0; e < 4; ++e) {
          o[2 * e] = a[2 * e] * rs * ngv[2 * e] * __uint_as_float(gg2[q][e] << 16);
          o[2 * e + 1] = a[2 * e + 1] * rs * ngv[2 * e + 1] * __uint_as_float(gg2[q][e] & 0xffff0000u);
        }
        u32x4 w; w.x = cvt_pk_bf16(o[0], o[1]); w.y = cvt_pk_bf16(o[2], o[3]); w.z = cvt_pk_bf16(o[4], o[5]); w.w = cvt_pk_bf16(o[6], o[7]);
        *(u32x4*)(c_hg + (size_t)(t + q) * HGW + lane * 8) = w;
      }
    }
#undef P2B_LOAD
  }
  GRID_BAR();
  {
    pg8::Gemm g{c_hg, WT_pb, HGW, 0, a_na, WT_pa, HGW / 64}; pg8::StaticOrder S; S.init(NTOK, D, G, bid);
    pg8::EpiGate<0> E{GA, GBT, merged};
    pg8::gemm_phase<pg8::EpiGate<0>, pg8::StaticOrder, true>(lds, g, S, E, (HGW + NAW) / 64);
  }
  GRID_BAR();
  {
    pg8::Gemm g{merged, WT_out, D, 0}; pg8::StaticOrder S; S.init(NTOK, D, G, bid);
    pg8::EpiBf16 E{T1, D};
    pg8::gemm_phase(lds, g, S, E);
  }
  GRID_BAR();
  { PHASE_IDS
    for (int i = bid * NT + tid; i < MAXROWS; i += G * NT) srt[i] = 0;
    LAS f32x4* WE = (LAS f32x4*)lds; LAS f32x4* WG = (LAS f32x4*)(lds + 131072); LAS u32x2* PRM = (LAS u32x2*)(lds + 147456);
    LAS int* lcnt = (LAS int*)(lds + 155648); LAS float* rbias = (LAS float*)(lds + 155648 + 128);
    {
      f32x4 tw[16], tg2[2];
#pragma unroll
      for (int k = 0; k < 16; ++k) { const int idx = tid + k * NT; tw[k] = *(const f32x4*)(w_re + (size_t)(idx >> 3) * NE + 4 * (idx & 7)); }
#pragma unroll
      for (int k = 0; k < 2; ++k) tg2[k] = *(const f32x4*)(w_rg + (size_t)(tid + k * NT) * NG);
#pragma unroll
      for (int k = 0; k < 16; ++k) { const int idx = tid + k * NT; const int row = idx >> 3, q = idx & 7, jj = row >> 6, l = (row >> 2) & 15, e = row & 3; WE[((jj * 4 + e) * 8 + q) * 16 + l] = tw[k]; }
#pragma unroll
      for (int k = 0; k < 2; ++k) { const int row = tid + k * NT; const int jj = row >> 6, l = (row >> 2) & 15, e = row & 3; WG[(jj * 4 + e) * 16 + l] = tg2[k]; }
    }
    for (int idx = tid; idx < 1024; idx += NT) { const int which = idx >> 8, c4 = idx & 255;
      const float* src = which == 0 ? emb_g : (which == 1 ? emb_b : (which == 2 ? ln1_g : ln1_b)); f32x4 pv = *(const f32x4*)(src + 4 * c4); if (which == 1) pv = pv * ALPHA;
      u32x2 pk; pk.x = pk2h(pv.x, pv.y); pk.y = pk2h(pv.z, pv.w); PRM[(which * 16 + (c4 >> 4)) * 16 + (c4 & 15)] = pk; }
    if (tid < NE) { lcnt[tid] = 0; rbias[4 + tid] = b_re[tid]; } if (tid < NG) rbias[tid] = b_rg[tid];
    __syncthreads();
    const int l16 = lane & 15, tg = lane >> 4;
    constexpr float LOG2E = 1.4426950408889634f;
#define P3D_H4(w_) (f32x4){h2f((unsigned short)((w_).x & 0xffffu)), h2f((unsigned short)((w_).x >> 16)), h2f((unsigned short)((w_).y & 0xffffu)), h2f((unsigned short)((w_).y >> 16))}
    u32x2 xn[16], mn[16];
#define P3D_LOAD(t_) do { const u32x2* xr_ = (const u32x2*)(hb + (size_t)(t_) * D) + l16; const u32x2* mr_ = (const u32x2*)(T1 + (size_t)(t_) * D) + l16; \
      _Pragma("unroll") for (int jj = 0; jj < 16; ++jj) { xn[jj] = xr_[16 * jj]; mn[jj] = mr_[16 * jj]; } } while (0)
    P3D_LOAD(bid * 256 + wid * 32 + tg);
#pragma unroll 1
    for (int it = 0; it < 8; ++it) {
      const int t = bid * 256 + wid * 32 + 4 * it + tg;
      f32x4 v[16]; float s = 0.f;
      {
        u32x2 hv[16], mv[16];
#pragma unroll
        for (int jj = 0; jj < 16; ++jj) { hv[jj] = xn[jj]; mv[jj] = mn[jj]; }
        if (it < 7) P3D_LOAD(t + 4);
#pragma unroll
        for (int jj = 0; jj < 16; ++jj) {
          const f32x4 hx4 = (f32x4){__uint_as_float(hv[jj].x << 16), __uint_as_float(hv[jj].x & 0xffff0000u), __uint_as_float(hv[jj].y << 16), __uint_as_float(hv[jj].y & 0xffff0000u)};
          const f32x4 mx4 = (f32x4){__uint_as_float(mv[jj].x << 16), __uint_as_float(mv[jj].x & 0xffff0000u), __uint_as_float(mv[jj].y << 16), __uint_as_float(mv[jj].y & 0xffff0000u)};
          v[jj] = hx4 * ALPHA + mx4;
          s += (v[jj].x + v[jj].y) + (v[jj].z + v[jj].w);
        }
      }
      const float mean = row_sum16(s) * (1.f / D); float s2 = 0.f;
#pragma unroll
      for (int jj = 0; jj < 16; ++jj) { v[jj] = v[jj] - mean; s2 += (v[jj].x * v[jj].x + v[jj].y * v[jj].y) + (v[jj].z * v[jj].z + v[jj].w * v[jj].w); }
      const float rstd = rsqrtf(row_sum16(s2) * (1.f / D) + LN_EPS);
      float gl[NG];
#pragma unroll
      for (int i = 0; i < NG; ++i) gl[i] = 0.f;
      u32x2* o8 = (u32x2*)(h1b + (size_t)t * D) + l16;
#pragma unroll
      for (int jj = 0; jj < 16; ++jj) {
        const f32x4 lg = P3D_H4(PRM[(2 * 16 + jj) * 16 + l16]), lb_ = P3D_H4(PRM[(3 * 16 + jj) * 16 + l16]);
        const f32x4 o = v[jj] * rstd * lg + lb_;
        v[jj] = o;
        u32x2 w; w.x = cvt_pk_bf16(o.x, o.y); w.y = cvt_pk_bf16(o.z, o.w); o8[16 * jj] = w;
#pragma unroll
        for (int e = 0; e < 4; ++e) {
          const f32x4 wg = WG[(jj * 4 + e) * 16 + l16];
          gl[0] = fmaf(o[e], wg.x, gl[0]); gl[1] = fmaf(o[e], wg.y, gl[1]); gl[2] = fmaf(o[e], wg.z, gl[2]); gl[3] = fmaf(o[e], wg.w, gl[3]);
        }
      }
#pragma unroll
      for (int i = 0; i < NG; ++i) gl[i] = row_sum16(gl[i]) + rbias[i];
      int gs = 0; float gm = gl[0];
#pragma unroll
      for (int i = 1; i < NG; ++i) if (gl[i] > gm) { gm = gl[i]; gs = i; }
      float gden = 0.f;
#pragma unroll
      for (int i = 0; i < NG; ++i) gden += __builtin_amdgcn_exp2f((gl[i] - gm) * LOG2E);
      const float gwt = 1.f / gden;
      float ev[EPG];
#pragma unroll
      for (int i = 0; i < EPG; ++i) ev[i] = 0.f;
      const LAS f32x4* wes = WE + (2 * gs) * 16 + l16;
#pragma unroll
      for (int jj = 0; jj < 16; ++jj) {
#pragma unroll
        for (int e = 0; e < 4; ++e) {
          const f32x4 wa = wes[(jj * 4 + e) * 8 * 16], wb = wes[(jj * 4 + e) * 8 * 16 + 16]; const float ov = v[jj][e];
          ev[0] = fmaf(ov, wa.x, ev[0]); ev[1] = fmaf(ov, wa.y, ev[1]); ev[2] = fmaf(ov, wa.z, ev[2]); ev[3] = fmaf(ov, wa.w, ev[3]);
          ev[4] = fmaf(ov, wb.x, ev[4]); ev[5] = fmaf(ov, wb.y, ev[5]); ev[6] = fmaf(ov, wb.z, ev[6]); ev[7] = fmaf(ov, wb.w, ev[7]);
        }
      }
#pragma unroll
      for (int i = 0; i < EPG; ++i) ev[i] = row_sum16(ev[i]) + rbias[4 + gs * EPG + i];
      int i0 = 0; float m0 = ev[0];
#pragma unroll
      for (int i = 1; i < EPG; ++i) if (ev[i] > m0) { m0 = ev[i]; i0 = i; }
      int i1 = -1; float m1v = -3.0e38f;
#pragma unroll
      for (int i = 0; i < EPG; ++i) if (i != i0 && ev[i] > m1v) { m1v = ev[i]; i1 = i; }
      const float p1 = __builtin_amdgcn_exp2f((m1v - m0) * LOG2E);
      if (l16 == 0) {
        const int e0 = gs * EPG + i0, e1 = gs * EPG + i1;
        tok_w[2 * t] = gwt / (1.f + p1); tok_w[2 * t + 1] = gwt * p1 / (1.f + p1);
        tok_e[2 * t] = e0; tok_e[2 * t + 1] = e1;
        tok_p[2 * t] = __hip_atomic_fetch_add(lcnt + e0, 1, __ATOMIC_RELAXED, __HIP_MEMORY_SCOPE_WORKGROUP);
        tok_p[2 * t + 1] = __hip_atomic_fetch_add(lcnt + e1, 1, __ATOMIC_RELAXED, __HIP_MEMORY_SCOPE_WORKGROUP);
      }
    }
#undef P3D_H4
#undef P3D_LOAD
    __syncthreads();
    if (tid < NE) blk_base[bid * NE + tid] = atomicAdd(&cnt[tid], lcnt[tid]);
    __syncthreads();
  }
  GRID_BAR();
  { PHASE_IDS
    LAS int* loff = (LAS int*)lds;
    if (tid < 64) {
      const int e = lane; const int c_e = (e < NE) ? cnt[e] : 0; const int nt_e = (c_e + 255) >> 8;
      int incl = nt_e;
#pragma unroll
      for (int d = 1; d < 32; d <<= 1) { const int v = __shfl_up(incl, d); if (lane >= d) incl += v; }
      const int start = (incl - nt_e) << 8;
      if (e < NE) loff[e] = start;
      if (e == NE - 1) loff[NE] = incl << 8;
      if (bid == 0) {
        if (e < NE) { for (int q = 0; q < nt_e; ++q) tile_e[(start >> 8) + q] = e; offs[e] = start; }
        if (e == NE - 1) { *nmt_p = incl; offs[NE] = incl << 8; }
      }
    }
    __syncthreads();
    for (int it = bid * NT + tid; it < NTOK * 2; it += G * NT) {
      const int t = it >> 1; const int ee = tok_e[it];
      const int row = loff[ee] + blk_base[(t >> 8) * NE + ee] + tok_p[it];
      srt[row] = t; tok_p[it] = row;
    }
    __syncthreads();
  }
  GRID_BAR();
  {
    const int nmt = *nmt_p;
    {
      LAS int* le = (LAS int*)(lds + pg8::GEMM_LE_OFF);
      if (threadIdx.x < 16) { const int pm = (int)threadIdx.x * (G >> 2) + ((bid >> 3) >> 2) * 8 + (bid & 7); le[threadIdx.x] = pm < nmt ? tile_e[pm] : 0; }
      __syncthreads();
    }
    pg8::Gemm g{h1b, WT_gu, D, (size_t)1024 * D * 2, nullptr, nullptr, 0, srt}; pg8::GroupedOrder S{(const LAS int*)(lds + pg8::GEMM_LE_OFF), nmt, G, bid};
    pg8::EpiSwiGLU E{hid};
    pg8::gemm_phase<pg8::EpiSwiGLU, pg8::GroupedOrder, false, true>(lds, g, S, E);
  }
  GRID_BAR();
  {
    pg8::Gemm g{hid, WT_d, DFF, (size_t)1024 * DFF * 2}; pg8::GroupedOrder S{(const LAS int*)(lds + pg8::GEMM_LE_OFF), *nmt_p, G, bid};
    pg8::EpiBf16 E{ybuf, D};
    pg8::gemm_phase(lds, g, S, E);
  }
  GRID_BAR();
  { PHASE_IDS
    f32x4 gq4[4], bq4[4];
#pragma unroll
    for (int j = 0; j < 4; ++j) { gq4[j] = ((const f32x4*)ln2_g)[lane + 64 * j]; bq4[j] = ((const f32x4*)ln2_b)[lane + 64 * j]; }
    u32x2 hbv[4], yav[4], ycv[4];
    int rA = 0, rB = 0; float wA = 0.f, wB = 0.f;
#define P5_IDX(t_) do { rA = tok_p[2 * (t_)]; rB = tok_p[2 * (t_) + 1]; wA = tok_w[2 * (t_)]; wB = tok_w[2 * (t_) + 1]; } while (0)
#define P5_LOAD(t_) do { \
      const u32x2* hb_ = (const u32x2*)(h1b + (size_t)(t_) * D) + lane; const u32x2* ya_ = (const u32x2*)(ybuf + (size_t)rA * D) + lane; const u32x2* yc_ = (const u32x2*)(ybuf + (size_t)rB * D) + lane; \
      _Pragma("unroll") for (int j = 0; j < 4; ++j) { hbv[j] = hb_[64 * j]; yav[j] = ya_[64 * j]; ycv[j] = yc_[64 * j]; } } while (0)
    float w0n = 0.f, w1n = 0.f;
    if (gw < NTOK) { P5_IDX(gw); P5_LOAD(gw); w0n = wA; w1n = wB; if (gw + NGW < NTOK) P5_IDX(gw + NGW); }
    for (int t = gw; t < NTOK; t += NGW) {
      f32x4 v[4]; float s = 0.f; const float w0 = w0n, w1 = w1n;
#pragma unroll
      for (int j = 0; j < 4; ++j) {
        const u32x2 hb2 = hbv[j], a = yav[j], c = ycv[j];
        const f32x4 hv = (f32x4){__uint_as_float(hb2.x << 16), __uint_as_float(hb2.x & 0xffff0000u), __uint_as_float(hb2.y << 16), __uint_as_float(hb2.y & 0xffff0000u)};
        const f32x4 ya = (f32x4){__uint_as_float(a.x << 16), __uint_as_float(a.x & 0xffff0000u), __uint_as_float(a.y << 16), __uint_as_float(a.y & 0xffff0000u)};
        const f32x4 yc = (f32x4){__uint_as_float(c.x << 16), __uint_as_float(c.x & 0xffff0000u), __uint_as_float(c.y << 16), __uint_as_float(c.y & 0xffff0000u)};
        v[j] = hv * ALPHA + (ya * w0 + yc * w1);
        s += (v[j].x + v[j].y) + (v[j].z + v[j].w);
      }
      if (t + NGW < NTOK) { P5_LOAD(t + NGW); w0n = wA; w1n = wB; if (t + 2 * NGW < NTOK) P5_IDX(t + 2 * NGW); }
      const float mean = wave_sum(s) * (1.f / D); float s2 = 0.f;
#pragma unroll
      for (int j = 0; j < 4; ++j) { v[j] = v[j] - mean; s2 += (v[j].x * v[j].x + v[j].y * v[j].y) + (v[j].z * v[j].z + v[j].w * v[j].w); }
      const float rstd = rsqrtf(wave_sum(s2) * (1.f / D) + LN_EPS);
      f32x4* hr = (f32x4*)(h1 + (size_t)t * D) + lane;
#pragma unroll
      for (int j = 0; j < 4; ++j) hr[64 * j] = v[j] * rstd * gq4[j] + bq4[j];
    }
#undef P5_IDX
#undef P5_LOAD
  }
}

extern "C" void kernel_launch(void* const* d_in, const int* in_sizes, int n_in, void* d_out, int out_size,
                              void* d_ws, size_t ws_size, hipStream_t stream) {
  constexpr size_t kDynLds = LDS_BYTES;
  static int grid_blocks = 0;
  if (!grid_blocks) {
    int dev = 0, cus = 0, per_cu = 0;
    (void)hipGetDevice(&dev);
    (void)hipDeviceGetAttribute(&cus, hipDeviceAttributeMultiprocessorCount, dev);
    (void)hipFuncSetAttribute((const void*)fwd_megakernel, hipFuncAttributeMaxDynamicSharedMemorySize, (int)kDynLds);
    (void)hipOccupancyMaxActiveBlocksPerMultiprocessor(&per_cu, fwd_megakernel, NT, kDynLds);
    if (per_cu < 1) fprintf(stderr, "occupancy query says %d blocks per CU\n", per_cu);
    grid_blocks = 256;
    if (cus < 256) fprintf(stderr, "device has %d CUs; this kernel needs 256 resident workgroups\n", cus);
    if (ws_size < WS_END) fprintf(stderr, "workspace too small: %zu < %zu\n", ws_size, (size_t)WS_END);
  }
  Params p{};
  for (int i = 0; i < 21; ++i) p.in[i] = (const float*)d_in[i];
  p.out = (float*)d_out; p.ws = (unsigned char*)d_ws;
  void* args[] = {&p};
  hipError_t e = hipLaunchCooperativeKernel((void*)fwd_megakernel, dim3(grid_blocks), dim3(NT), args, kDynLds, stream);
  if (e != hipSuccess) fprintf(stderr, "cooperative launch failed: %s (grid %d)\n", hipGetErrorString(e), grid_blocks);
}
```

```cpp
#include <hip/hip_runtime.h>
#include <hip/hip_cooperative_groups.h>
#include <cstdio>
namespace cg = cooperative_groups;

#define LAS __attribute__((address_space(3)))
typedef unsigned short bf16_t;
typedef short bf16x8 __attribute__((ext_vector_type(8)));
typedef float f32x4 __attribute__((ext_vector_type(4)));
typedef float f32x2 __attribute__((ext_vector_type(2)));
typedef unsigned u32x4 __attribute__((ext_vector_type(4)));
typedef unsigned u32x2 __attribute__((ext_vector_type(2)));
typedef float f32x16 __attribute__((ext_vector_type(16)));
#define MFMA32(a, b, c) __builtin_amdgcn_mfma_f32_32x32x16_bf16((a), (b), (c), 0, 0, 0)

constexpr int D = 1024, NB = 8, SEQ = 8192, NTOK = NB * SEQ, GW = 64, ROWS = SEQ / GW;
constexpr int NAH = 8, NADH = 64, NAW = 512, KH = 8, KW = 16;
constexpr int HGH = 4, HGD = 128, HGW = 512;
constexpr int DIN = 6144;
constexpr int NE = 32, EPG = 8, NG = 4, DFF = 512;
constexpr float ALPHA = 1.189207115002721f;
constexpr float LN_EPS = 1e-5f, RMS_EPS = 1e-6f;
constexpr int NT = 512;
constexpr int MAXROWS = NTOK * 2 + NE * 256;
constexpr int MAXMT = MAXROWS / 256;

constexpr size_t MiB = 1u << 20;
constexpr size_t WS_BAR = 65536;
constexpr size_t WS_CTRL = 0;
constexpr size_t WS_WT_IN = 1 * MiB, WS_WT_PA = 13 * MiB, WS_WT_PB = 14 * MiB, WS_WT_OUT = 15 * MiB, WS_WT_GU = 17 * MiB, WS_WT_D = 81 * MiB;
constexpr size_t WS_HB = 113 * MiB;
constexpr size_t WS_ANA = 113 * MiB, WS_CHG = 177 * MiB, WS_HID = 113 * MiB;
constexpr size_t WS_U0 = 241 * MiB;
constexpr size_t WS_NAQ = WS_U0, WS_NAK = WS_U0 + 64 * MiB, WS_NAV = WS_U0 + 128 * MiB, WS_HQ = WS_U0 + 192 * MiB, WS_GF = WS_U0 + 256 * MiB,
                 WS_GB = WS_U0 + 320 * MiB, WS_HI = WS_U0 + 384 * MiB, WS_HG = WS_U0 + 448 * MiB, WS_GA = WS_U0 + 512 * MiB, WS_GBT = WS_U0 + 640 * MiB;
constexpr size_t WS_T1 = 241 * MiB, WS_MERGED = 369 * MiB, WS_H1B = 497 * MiB, WS_XG = 625 * MiB, WS_Y = 625 * MiB;
constexpr size_t WS_STATS = 1009 * MiB, WS_TOKE = 1010 * MiB, WS_TOKP = 1011 * MiB, WS_TOKW = 1012 * MiB, WS_END = 1013 * MiB;

struct Params { const float* in[21]; float* out; unsigned char* ws; };

__device__ __forceinline__ int opq(int v) { asm volatile("" : "+v"(v)); return v; }
template <int CTRL> __device__ __forceinline__ float dpp_mov(float x) { return __uint_as_float((unsigned)__builtin_amdgcn_update_dpp(0, (int)__float_as_uint(x), CTRL, 0xF, 0xF, false)); }
__device__ __forceinline__ float row_sum16(float x) {
  x += dpp_mov<0xB1>(x);
  x += dpp_mov<0x4E>(x);
  x += dpp_mov<0x141>(x);
  x += dpp_mov<0x140>(x);
  return x;
}
__device__ __forceinline__ float lane_bcast(float x, int l) { return __uint_as_float((unsigned)__builtin_amdgcn_readlane((int)__float_as_uint(x), l)); }
__device__ __forceinline__ float wave_sum(float v) {
  v = row_sum16(v);
  return (lane_bcast(v, 0) + lane_bcast(v, 16)) + (lane_bcast(v, 32) + lane_bcast(v, 48));
}
__device__ __forceinline__ float half_swap_max(float x) { const auto r = __builtin_amdgcn_permlane32_swap(__float_as_uint(x), __float_as_uint(x), false, false); return fmaxf(__uint_as_float(r[0]), __uint_as_float(r[1])); }
__device__ __forceinline__ float half_swap_sum(float x) { const auto r = __builtin_amdgcn_permlane32_swap(__float_as_uint(x), __float_as_uint(x), false, false); return __uint_as_float(r[0]) + __uint_as_float(r[1]); }
__device__ __forceinline__ float bf2f(unsigned short b) { return __uint_as_float(((unsigned)b) << 16); }
__device__ __forceinline__ unsigned f2bf(float f) { unsigned u = __float_as_uint(f); return (u + 0x7fffu + ((u >> 16) & 1u)) >> 16; }
__device__ __forceinline__ unsigned pk2(float lo, float hi) { return f2bf(lo) | (f2bf(hi) << 16); }
typedef __bf16 bf16x2_t __attribute__((ext_vector_type(2)));
__device__ __forceinline__ unsigned cvt_pk_bf16(float lo, float hi) { const bf16x2_t v = {(__bf16)lo, (__bf16)hi}; return __builtin_bit_cast(unsigned, v); }
__device__ __forceinline__ unsigned pk2h(float lo, float hi) { const _Float16 a = (_Float16)lo, b = (_Float16)hi; return (unsigned)__builtin_bit_cast(unsigned short, a) | ((unsigned)__builtin_bit_cast(unsigned short, b) << 16); }
__device__ __forceinline__ float h2f(unsigned short h) { return (float)__builtin_bit_cast(_Float16, h); }
__device__ __forceinline__ float sigm(float x) { return __builtin_amdgcn_rcpf(1.0f + __expf(-x)); }
__device__ __forceinline__ float silu(float x) { return x * __builtin_amdgcn_rcpf(1.0f + __expf(-x)); }

__device__ __forceinline__ void st_wt8(void* p, u32x2 v) { __hip_atomic_store((unsigned long long*)p, (unsigned long long)v.x | ((unsigned long long)v.y << 32), __ATOMIC_RELAXED, __HIP_MEMORY_SCOPE_AGENT); }
__device__ __forceinline__ void st_wt16(void* p, u32x4 v) { asm volatile("global_store_dwordx4 %0, %1, off sc1\n\ts_nop 1" :: "v"(p), "v"(v) : "memory"); }

namespace pg8 {
constexpr int BM = 256, BK = 64, HALF = 128, HTB = HALF * BK * 2, STAGE_BYTES = 8 * HTB, NXCD = 8, WGM = 8;
__host__ __device__ __forceinline__ int lds_byte(int r, int c) { const int st = (r >> 4) * 2 + (c >> 5), rr = r & 15, cc = c & 31, ob = rr * 64 + cc * 2; return st * 1024 + (ob ^ (((ob >> 9) & 1) << 5)); }
__host__ __device__ __forceinline__ void stage_rc(int b, int& R, int& C) { const int st = b / 1024, sb = b % 1024, swz = sb ^ (((sb >> 9) & 1) << 5); R = (st >> 1) * 16 + swz / 64; C = (st & 1) * 32 + (swz % 64) / 2; }
__host__ __device__ __forceinline__ int perm32(int rho) { const int n = rho >> 4, i = rho & 15; return 8 * (i >> 2) + 4 * n + (i & 3); }

struct Unit { int pm, pn, e; };
struct Gemm { const bf16_t* A; const bf16_t* Bt; int K; size_t b_estride; const bf16_t* A2; const bf16_t* B2; int nt1; const int* rowlist; };

struct StaticOrder {
  int nM, nN, nwg, G, c, nrd, wgm; bool rev;
  __device__ void init(int M, int N, int G_, int c_, bool rev_ = false, int wgm_ = WGM) { nM = M / BM; nN = N / BM; nwg = nM * nN; G = G_; c = c_; rev = rev_; wgm = wgm_; nrd = c < nwg ? (nwg - c + G - 1) / G : 0; }
  __device__ bool next(int i, Unit& u) const {
    if (i >= nrd) return false;
    const long L = (long)(rev ? nrd - 1 - i : i) * G + c;
    int wgid = (int)L; { const int q = nwg / NXCD, r = nwg % NXCD, xcd = wgid % NXCD, off = wgid / NXCD; wgid = (xcd < r ? xcd * (q + 1) : r * (q + 1) + (xcd - r) * q) + off; }
    const int nig = wgm * nN, gid = wgid / nig, fm = gid * wgm, gsz = (nM - fm) < wgm ? (nM - fm) : wgm;
    u.pm = fm + ((wgid % nig) % gsz); u.pn = (wgid % nig) / gsz; if (gid & 1) u.pn = nN - 1 - u.pn;
    u.e = 0; return true;
  }
};
struct GroupedOrder {
  const LAS int* le; int nmt, G, c; bool rev;
  __device__ bool next(int i, Unit& u) const {
    const int x = c & 7, sidx = c >> 3, k = sidx >> 2, per = (nmt + 7) >> 3;
    int cnt = nmt - x * per; cnt = cnt < 0 ? 0 : (cnt > per ? per : cnt);
    const int n = cnt > k ? (cnt - k + 7) >> 3 : 0; if (i >= n) return false;
    const int ii = rev ? n - 1 - i : i;
    u.pm = x * per + ii * 8 + k; u.pn = sidx & 3; u.e = le[ii]; return true;
  }
};
constexpr int GEMM_LE_OFF = 131072;
constexpr int GEMM_RL_OFF = 131072 + 1024;

constexpr bool kSP2 = true;
constexpr bool kALIGN = true;
template <class Epi, class Sched, bool DUAL = false, bool GATHER = false, bool SP2 = kSP2, bool ALIGN_EPI = kALIGN>
__device__ __forceinline__ void gemm_phase(LAS unsigned char* lds, const Gemm g, const Sched& S, const Epi& E, int ntiles = 0) {
  const int tid = opq(threadIdx.x), wid = __builtin_amdgcn_readfirstlane(tid >> 6), lane = tid & 63, wr = wid >> 2, wc = wid & 3, fr = lane & 15, fq = lane >> 4;
  const int K = g.K, nt = DUAL ? ntiles : K / BK;
  unsigned voffA[2], voffB[2];
#pragma unroll
  for (int i = 0; i < 2; ++i) { int R, C; stage_rc(tid * 16 + i * 8192, R, C);
    const int Rb = Epi::PERM ? ((Epi::BJ32 ? 64 * (R >> 5) : (R & ~31)) + perm32(R & 31)) : R;
    voffA[i] = (unsigned)(R * K + C) * 2u; voffB[i] = (unsigned)(Rb * K + C) * 2u; }
  const size_t kstep = (size_t)(BK * 2);
  const size_t hstep = (size_t)HALF * K * 2;
  const size_t hstepB = Epi::BJ32 ? (size_t)32 * K * 2 : hstep;
  const size_t tstep = 2 * hstep;
  const unsigned ldsw = (unsigned)wid * 1024u;
  const int aoff = lds_byte(wr * 64 + fr, fq * 8), boff = lds_byte(wc * 32 + fr, fq * 8);
#define PG8_SA(b, h) (((b) * 2 + (h)) * HTB)
#define PG8_SB(b, h) ((4 + (b) * 2 + (h)) * HTB)
#define PG8_STAGE(bufoff, gbase, voff) do { _Pragma("unroll") for (int _i = 0; _i < 2; ++_i) \
    __builtin_amdgcn_global_load_lds((const unsigned*)((const char*)(gbase) + (voff)[_i]), (LAS unsigned*)(lds + (bufoff) + ldsw + _i * 8192), 16, 0, 0); } while (0)
#define PG8_LDA(dst, b, h) do { _Pragma("unroll") for (int m = 0; m < 4; ++m) _Pragma("unroll") for (int k = 0; k < 2; ++k) dst[m][k] = *(const LAS bf16x8*)(lds + PG8_SA(b, h) + aoff + m * 2048 + k * 1024); } while (0)
#define PG8_LDB(dst, b, h) do { _Pragma("unroll") for (int n = 0; n < 2; ++n) _Pragma("unroll") for (int k = 0; k < 2; ++k) dst[n][k] = *(const LAS bf16x8*)(lds + PG8_SB(b, h) + boff + n * 2048 + k * 1024); } while (0)
#define PG8_MMA(ai, bj, At, Bt) do { __builtin_amdgcn_s_setprio(1); _Pragma("unroll") for (int m = 0; m < 4; ++m) _Pragma("unroll") for (int n = 0; n < 2; ++n) _Pragma("unroll") for (int k = 0; k < 2; ++k) \
    acc[ai][bj][m][n] = __builtin_amdgcn_mfma_f32_16x16x32_bf16(Bt[n][k], At[m][k], acc[ai][bj][m][n], 0, 0, 0); __builtin_amdgcn_s_setprio(0); } while (0)
#define PG8_WAIT_V(n) asm volatile("s_waitcnt vmcnt(" #n ")" ::: "memory")
#define PG8_WAIT_L(n) asm volatile("s_waitcnt lgkmcnt(" #n ")" ::: "memory")
#define PG8_BAR __builtin_amdgcn_s_barrier()
#define PG8_SCHED __builtin_amdgcn_sched_barrier(0)
  Unit cur, nxt; int ui = 0;
  if (!S.next(0, cur)) return;
  f32x4 acc[2][2][4][2];
#pragma unroll
  for (int a = 0; a < 2; ++a)
#pragma unroll
    for (int b = 0; b < 2; ++b)
#pragma unroll
      for (int m = 0; m < 4; ++m)
#pragma unroll
        for (int n = 0; n < 2; ++n) acc[a][b][m][n] = (f32x4){0.f, 0.f, 0.f, 0.f};
  bf16x8 At[4][2], B0[2][2], B1[2][2];
  const char* cA = (const char*)g.A + (size_t)cur.pm * tstep; const char* cB = (const char*)g.Bt + (size_t)cur.e * g.b_estride + (size_t)cur.pn * tstep;
  const char* cA2 = DUAL ? (const char*)g.A2 + (size_t)cur.pm * tstep : cA; const char* cB2 = DUAL ? (const char*)g.B2 + (size_t)cur.pn * tstep : cB;
  unsigned gA[2][2] = {{0u, 0u}, {0u, 0u}};
  int gR[2], gC[2];
#pragma unroll
  for (int i = 0; i < 2; ++i) stage_rc(tid * 16 + i * 8192, gR[i], gC[i]);
#define PG8_ROWS(dst, un) do { _Pragma("unroll") for (int h_ = 0; h_ < 2; ++h_) _Pragma("unroll") for (int i_ = 0; i_ < 2; ++i_) \
    dst[h_][i_] = (unsigned)(g.rowlist[(un).pm * BM + h_ * HALF + gR[i_]] * K + gC[i_]) * 2u; } while (0)
  if constexpr (GATHER) { PG8_ROWS(gA, cur); cA = (const char*)g.A; }
#define PG8_RLV(h_, i_) ((unsigned)(*(const LAS int*)(lds + GEMM_RL_OFF + ((ui + 1) & 1) * 1024 + ((h_) * HALF + gR[i_]) * 4) * K + gC[i_]) * 2u)
  if constexpr (SP2) {
    PG8_STAGE(PG8_SB(0, 0), cB, voffB); PG8_STAGE(PG8_SB(0, 1), cB + hstepB, voffB);
    if constexpr (GATHER) { PG8_STAGE(PG8_SA(0, 0), cA, gA[0]); PG8_STAGE(PG8_SA(0, 1), cA, gA[1]); } else { PG8_STAGE(PG8_SA(0, 0), cA, voffA); PG8_STAGE(PG8_SA(0, 1), cA + hstep, voffA); }
    if (wr == 1) PG8_BAR;
    PG8_WAIT_V(2); PG8_BAR;
  } else {
  PG8_STAGE(PG8_SB(0, 0), cB, voffB); if constexpr (GATHER) PG8_STAGE(PG8_SA(0, 0), cA, gA[0]); else PG8_STAGE(PG8_SA(0, 0), cA, voffA);
  PG8_STAGE(PG8_SB(0, 1), cB + hstepB, voffB); if constexpr (GATHER) PG8_STAGE(PG8_SA(0, 1), cA, gA[1]); else PG8_STAGE(PG8_SA(0, 1), cA + hstep, voffA);
  if (wr == 1) PG8_BAR;
  PG8_WAIT_V(4); PG8_BAR;
  }
  PG8_STAGE(PG8_SB(1, 0), cB + kstep, voffB); if constexpr (GATHER) PG8_STAGE(PG8_SA(1, 0), cA + kstep, gA[0]); else PG8_STAGE(PG8_SA(1, 0), cA + kstep, voffA);
  PG8_STAGE(PG8_SB(1, 1), cB + hstepB + kstep, voffB);
  PG8_WAIT_V(6); PG8_BAR;
  for (;;) {
    const bool has_next = S.next(ui + 1, nxt);
    const char* nA = GATHER ? (const char*)g.A : (has_next ? (const char*)g.A + (size_t)nxt.pm * tstep : cA);
    if constexpr (GATHER) {
      if (has_next && wid == 0) __builtin_amdgcn_global_load_lds((const unsigned*)(g.rowlist + nxt.pm * BM) + lane * 4, (LAS unsigned*)(lds + GEMM_RL_OFF + ((ui + 1) & 1) * 1024), 16, 0, 0); }
    const char* nB = has_next ? (const char*)g.Bt + (size_t)nxt.e * g.b_estride + (size_t)nxt.pn * tstep : cB;
    for (int t = 0; t < nt; t += 2) {
      const bool last = (t == nt - 2);
      const char* a1 = (DUAL && t >= g.nt1) ? cA2 + (size_t)(t + 1 - g.nt1) * kstep : cA + (size_t)(t + 1) * kstep;
      const char* a2 = last ? nA : ((DUAL && t + 2 >= g.nt1) ? cA2 + (size_t)(t + 2 - g.nt1) * kstep : cA + (size_t)(t + 2) * kstep);
      const char* b2 = last ? nB : ((DUAL && t + 2 >= g.nt1) ? cB2 + (size_t)(t + 2 - g.nt1) * kstep : cB + (size_t)(t + 2) * kstep);
      const char* a3 = a2 + kstep; const char* b3 = b2 + kstep;
      if constexpr (DUAL) { if (t == g.nt1) E.mid(acc, cur, wr, wc, fr, fq); }
      unsigned vA0[2], vA1[2];
      if constexpr (GATHER) { const bool ln_ = last && has_next; _Pragma("unroll") for (int i_ = 0; i_ < 2; ++i_) { const unsigned n0_ = PG8_RLV(0, i_), n1_ = PG8_RLV(1, i_); vA0[i_] = ln_ ? n0_ : gA[0][i_]; vA1[i_] = ln_ ? n1_ : gA[1][i_]; } }
      if constexpr (SP2) {
      PG8_LDB(B0, 0, 0); PG8_LDB(B1, 0, 1); PG8_SCHED; PG8_LDA(At, 0, 0); if constexpr (GATHER) PG8_STAGE(PG8_SA(1, 1), a1, gA[1]); else PG8_STAGE(PG8_SA(1, 1), a1 + hstep, voffA);
      PG8_WAIT_V(8); PG8_WAIT_L(0); PG8_BAR; PG8_MMA(0, 0, At, B0); PG8_MMA(0, 1, At, B1); PG8_BAR; PG8_SCHED;
      PG8_LDA(At, 0, 1); PG8_STAGE(PG8_SB(0, 0), b2, voffB); PG8_STAGE(PG8_SB(0, 1), b2 + hstepB, voffB); if constexpr (GATHER) PG8_STAGE(PG8_SA(0, 0), a2, vA0); else PG8_STAGE(PG8_SA(0, 0), a2, voffA);
      PG8_WAIT_V(8); PG8_WAIT_L(0); PG8_BAR; PG8_MMA(1, 0, At, B0); PG8_MMA(1, 1, At, B1); PG8_BAR; PG8_SCHED;
      PG8_LDB(B0, 1, 0); PG8_LDB(B1, 1, 1); PG8_SCHED; PG8_LDA(At, 1, 0); if constexpr (GATHER) PG8_STAGE(PG8_SA(0, 1), a2, vA1); else PG8_STAGE(PG8_SA(0, 1), a2 + hstep, voffA);
      PG8_WAIT_V(8); PG8_WAIT_L(0); PG8_BAR; PG8_MMA(0, 0, At, B0); PG8_MMA(0, 1, At, B1); PG8_BAR; PG8_SCHED;
      PG8_LDA(At, 1, 1); PG8_STAGE(PG8_SB(1, 0), b3, voffB); PG8_STAGE(PG8_SB(1, 1), b3 + hstepB, voffB); if constexpr (GATHER) PG8_STAGE(PG8_SA(1, 0), a3, vA0); else PG8_STAGE(PG8_SA(1, 0), a3, voffA);
      PG8_WAIT_V(8); PG8_WAIT_L(0); PG8_BAR; PG8_MMA(1, 0, At, B0); PG8_MMA(1, 1, At, B1); PG8_BAR; PG8_SCHED;
      } else {
      PG8_LDB(B0, 0, 0); PG8_SCHED; PG8_LDA(At, 0, 0); if constexpr (GATHER) PG8_STAGE(PG8_SA(1, 1), a1, gA[1]); else PG8_STAGE(PG8_SA(1, 1), a1 + hstep, voffA);
      PG8_WAIT_L(8); PG8_BAR; PG8_WAIT_L(0); PG8_MMA(0, 0, At, B0); PG8_BAR; PG8_SCHED;
      PG8_LDB(B1, 0, 1); PG8_STAGE(PG8_SB(0, 0), b2, voffB);
      PG8_BAR; PG8_WAIT_L(0); PG8_MMA(0, 1, At, B1); PG8_BAR;
      PG8_LDA(At, 0, 1); if constexpr (GATHER) PG8_STAGE(PG8_SA(0, 0), a2, vA0); else PG8_STAGE(PG8_SA(0, 0), a2, voffA);
      PG8_BAR; PG8_WAIT_L(0); PG8_MMA(1, 0, At, B0); PG8_BAR; PG8_SCHED;
      PG8_STAGE(PG8_SB(0, 1), b2 + hstepB, voffB);
      PG8_WAIT_V(6); PG8_BAR; PG8_MMA(1, 1, At, B1); PG8_BAR;
      PG8_LDB(B0, 1, 0); PG8_SCHED; PG8_LDA(At, 1, 0); if constexpr (GATHER) PG8_STAGE(PG8_SA(0, 1), a2, vA1); else PG8_STAGE(PG8_SA(0, 1), a2 + hstep, voffA);
      PG8_WAIT_L(8); PG8_BAR; PG8_WAIT_L(0); PG8_MMA(0, 0, At, B0); PG8_BAR; PG8_SCHED;
      PG8_LDB(B1, 1, 1); PG8_STAGE(PG8_SB(1, 0), b3, voffB);
      PG8_BAR; PG8_WAIT_L(0); PG8_MMA(0, 1, At, B1); PG8_BAR;
      PG8_LDA(At, 1, 1); if constexpr (GATHER) PG8_STAGE(PG8_SA(1, 0), a3, vA0); else PG8_STAGE(PG8_SA(1, 0), a3, voffA);
      PG8_BAR; PG8_WAIT_L(0); PG8_MMA(1, 0, At, B0); PG8_BAR; PG8_SCHED;
      PG8_STAGE(PG8_SB(1, 1), b3 + hstepB, voffB);
      PG8_WAIT_V(6); PG8_BAR; PG8_MMA(1, 1, At, B1); PG8_BAR;
      }
    }
    if constexpr (ALIGN_EPI) { if (wr == 0) PG8_BAR; }
    if constexpr (Epi::HASWT) { if (has_next) E.template run<false>(acc, cur, wr, wc, fr, fq); else E.template run<true>(acc, cur, wr, wc, fr, fq); }
    else E(acc, cur, wr, wc, fr, fq);
    if (!has_next) break;
#pragma unroll
    for (int a = 0; a < 2; ++a)
#pragma unroll
      for (int b = 0; b < 2; ++b)
#pragma unroll
        for (int m = 0; m < 4; ++m)
#pragma unroll
          for (int n = 0; n < 2; ++n) acc[a][b][m][n] = (f32x4){0.f, 0.f, 0.f, 0.f};
    if constexpr (GATHER) { _Pragma("unroll") for (int h_ = 0; h_ < 2; ++h_) _Pragma("unroll") for (int i_ = 0; i_ < 2; ++i_) gA[h_][i_] = PG8_RLV(h_, i_); }
    cur = nxt; cA = nA; cB = nB; ++ui;
    if constexpr (ALIGN_EPI) { if (wr == 1) PG8_BAR; }
    if (DUAL) { cA2 = (const char*)g.A2 + (size_t)cur.pm * tstep; cB2 = (const char*)g.B2 + (size_t)cur.pn * tstep; }
  }
  PG8_WAIT_V(0);
  if constexpr (!ALIGN_EPI) { if (wr == 0) PG8_BAR; }
  PG8_BAR;
#undef PG8_ROWS
#undef PG8_RLV
#undef PG8_SA
#undef PG8_SB
#undef PG8_STAGE
#undef PG8_LDA
#undef PG8_LDB
#undef PG8_MMA
#undef PG8_WAIT_V
#undef PG8_WAIT_L
#undef PG8_BAR
#undef PG8_SCHED
}

struct EpiU {
  static constexpr bool PERM = true; static constexpr bool BJ32 = false; static constexpr bool HASWT = false;
  unsigned char* ubase; LAS unsigned char* scr; const LAS float* lb;
  __device__ __forceinline__ void run_kb(const f32x4 (&acc)[2][2][4][2], unsigned char* base, int row0, int col0) const {
    bf16_t* KB = (bf16_t*)base;
#pragma unroll
    for (int ai = 0; ai < 2; ++ai)
#pragma unroll
      for (int m = 0; m < 4; ++m) {
        const int t = row0 + ai * HALF + m * 16, tb8 = (t >> 13) * 8, grow = (t >> 6) & 127, c = t & 63;
#pragma unroll
        for (int bj = 0; bj < 2; ++bj) {
          const int kcol = col0 + bj * HALF;
          const f32x4 v0 = acc[ai][bj][m][0], v1 = acc[ai][bj][m][1];
          u32x4 w; w.x = cvt_pk_bf16(v0[0], v0[1]); w.y = cvt_pk_bf16(v0[2], v0[3]); w.z = cvt_pk_bf16(v1[0], v1[1]); w.w = cvt_pk_bf16(v1[2], v1[3]);
          *(u32x4*)(KB + ((size_t)(((tb8 + (kcol >> 6)) * 128 + grow) * 8 + ((kcol & 63) >> 3)) * 64 + c) * 8) = w;
        }
      }
  }
  __device__ __forceinline__ void run_vt(const f32x4 (&acc)[2][2][4][2], unsigned char* base, int row0, int col0, LAS unsigned char* scr, int fr, int fq) const {
    bf16_t* VT = (bf16_t*)base; const int lane = fq * 16 + fr, cb = col0 - 8 * fq;
#pragma unroll
    for (int ai = 0; ai < 2; ++ai) {
      const int t = (row0 - fr) + ai * HALF, tb8 = (t >> 13) * 8, grow = (t >> 6) & 127;
#pragma unroll
      for (int bj = 0; bj < 2; ++bj)
#pragma unroll
        for (int n = 0; n < 2; ++n) {
#pragma unroll
          for (int m = 0; m < 4; ++m)
#pragma unroll
            for (int j = 0; j < 4; ++j)
              *(LAS unsigned short*)(scr + ((((2 * m + (fr >> 3)) * 16 + 4 * fq + j) * 8) + (fr & 7)) * 2) = __builtin_bit_cast(unsigned short, (__bf16)acc[ai][bj][m][n][j]);
#pragma unroll
          for (int k = 0; k < 2; ++k) {
            const int q = lane + 64 * k, colblk = q >> 4, dl = q & 15;
            const u32x4 w = *(const LAS u32x4*)(scr + q * 16);
            const int vcol = cb + bj * HALF + 8 * (dl >> 2) + 4 * n + (dl & 3);
            *(u32x4*)(VT + ((size_t)(((tb8 + (vcol >> 6)) * 128 + grow) * 8 + colblk) * 64 + (vcol & 63)) * 8) = w;
          }
        }
    }
  }
  __device__ __forceinline__ void run_hit(const f32x4 (&acc)[2][2][4][2], unsigned char* base, int row0, int col0, LAS unsigned char* scr, int fr, int fq) const {
    bf16_t* HT = (bf16_t*)base; const int lane = fq * 16 + fr, cb = col0 - 8 * fq;
#pragma unroll
    for (int ai = 0; ai < 2; ++ai) {
      const int t = (row0 - fr) + ai * HALF, tb4 = (t >> 13) * 4, blk = (t >> 6) & 127;
#pragma unroll
      for (int bj = 0; bj < 2; ++bj)
#pragma unroll
        for (int n = 0; n < 2; ++n) {
#pragma unroll
          for (int m = 0; m < 4; ++m)
#pragma unroll
            for (int j = 0; j < 4; ++j)
              *(LAS unsigned short*)(scr + ((4 * fq + j) * 64 + 16 * m + fr) * 2) = __builtin_bit_cast(unsigned short, (__bf16)acc[ai][bj][m][n][j]);
#pragma unroll
          for (int k = 0; k < 2; ++k) {
            const int q = lane + 64 * k, vl = q >> 3, pc = q & 7;
            const u32x4 w = *(const LAS u32x4*)(scr + q * 16);
            const int hcol = cb + bj * HALF + 8 * (vl >> 2) + 4 * n + (vl & 3);
            *(u32x4*)(HT + ((size_t)((tb4 + (hcol >> 7)) * 128 + blk) * 128 + (hcol & 127)) * 64 + pc * 8) = w;
          }
        }
    }
  }
  template <int MODE>
  __device__ __forceinline__ void run(const f32x4 (&acc)[2][2][4][2], unsigned char* base, int ld, int row0, int col0, int lbcol0) const {
    f32x4 lbv[2][2];
    if (MODE == 2) {
#pragma unroll
      for (int bj = 0; bj < 2; ++bj)
#pragma unroll
        for (int n = 0; n < 2; ++n) lbv[bj][n] = *(const LAS f32x4*)(lb + lbcol0 + bj * HALF + 4 * n);
    }
#pragma unroll
    for (int ai = 0; ai < 2; ++ai)
#pragma unroll
      for (int m = 0; m < 4; ++m) {
        unsigned char* rowp = base + ((size_t)(row0 + ai * HALF + m * 16) * ld + col0) * 2;
#pragma unroll
        for (int bj = 0; bj < 2; ++bj) {
          f32x4 v[2] = {acc[ai][bj][m][0], acc[ai][bj][m][1]};
          u32x4 w;
#pragma unroll
          for (int n = 0; n < 2; ++n)
#pragma unroll
            for (int j = 0; j < 4; ++j) {
              float x = v[n][j];
              if (MODE == 1) x = silu(x);
              if (MODE == 2) { const float l = lbv[bj][n][j]; x = __logf(l + (1.f - l) * sigm(x)); }
              if (MODE == 3) x = sigm(x);
              if (MODE == 4) x *= 0.125f * 1.4426950408889634f;
              v[n][j] = x;
            }
          if (MODE == 2) { w.x = pk2h(v[0][0], v[0][1]); w.y = pk2h(v[0][2], v[0][3]); w.z = pk2h(v[1][0], v[1][1]); w.w = pk2h(v[1][2], v[1][3]); }
          else { w.x = cvt_pk_bf16(v[0][0], v[0][1]); w.y = cvt_pk_bf16(v[0][2], v[0][3]); w.z = cvt_pk_bf16(v[1][0], v[1][1]); w.w = cvt_pk_bf16(v[1][2], v[1][3]); }
          *(u32x4*)(rowp + bj * HALF * 2) = w;
        }
      }
  }
  __device__ __forceinline__ void operator()(const f32x4 (&acc)[2][2][4][2], const Unit& u, int wr, int wc, int fr, int fq) const {
    const int pn = u.pn, row0 = u.pm * BM + wr * 64 + fr, cw = wc * 32 + 8 * fq;
    if (pn < 16) {
      const int seg = pn >> 1; unsigned char* base = ubase + (size_t)seg * 64 * MiB; const int col0 = (pn & 1) * 256 + cw;
      if (seg == 0) run<4>(acc, base, 512, row0, col0, 0);
      else if (seg == 1) run_kb(acc, base, row0, col0);
      else if (seg == 2) run_vt(acc, base, row0, col0, scr + (wr * 4 + wc) * 2048, fr, fq);
      else if (seg == 6) run_hit(acc, base, row0, col0, scr + (wr * 4 + wc) * 2048, fr, fq);
      else if (seg == 3 || seg == 7) run<1>(acc, base, 512, row0, col0, 0);
      else if (seg == 4 || seg == 5) run<2>(acc, base, 512, row0, col0, (seg - 4) * 512 + col0);
      else run<0>(acc, base, 512, row0, col0, 0);
    } else {
      bf16_t* GAp = (bf16_t*)(ubase + 512 * MiB); bf16_t* RHp = (bf16_t*)(ubase + 640 * MiB);
      const int col0 = (pn - 16) * 128 + cw;
#pragma unroll
      for (int ai = 0; ai < 2; ++ai)
#pragma unroll
        for (int m = 0; m < 4; ++m) {
          const size_t ro = (size_t)(row0 + ai * HALF + m * 16) * 1024 + col0;
          float ga[8], rh[8];
#pragma unroll
          for (int n = 0; n < 2; ++n)
#pragma unroll
            for (int j = 0; j < 4; ++j) {
              const float ea = 1.f + __expf(-acc[ai][0][m][n][j]), eb = 1.f + __expf(-acc[ai][1][m][n][j]);
              ga[4 * n + j] = __builtin_amdgcn_rcpf(ea); rh[4 * n + j] = ea * __builtin_amdgcn_rcpf(eb);
            }
          u32x4 w; w.x = cvt_pk_bf16(ga[0], ga[1]); w.y = cvt_pk_bf16(ga[2], ga[3]); w.z = cvt_pk_bf16(ga[4], ga[5]); w.w = cvt_pk_bf16(ga[6], ga[7]);
          *(u32x4*)(GAp + ro) = w;
          w.x = cvt_pk_bf16(rh[0], rh[1]); w.y = cvt_pk_bf16(rh[2], rh[3]); w.z = cvt_pk_bf16(rh[4], rh[5]); w.w = cvt_pk_bf16(rh[6], rh[7]);
          *(u32x4*)(RHp + ro) = w;
        }
    }
  }
};
template <int MODE> struct EpiGate {
  static constexpr bool PERM = true; static constexpr bool BJ32 = false; static constexpr bool HASWT = false;
  const bf16_t* G1; const bf16_t* T; bf16_t* O;
  __device__ __forceinline__ void mid(f32x4 (&acc)[2][2][4][2], const Unit& u, int wr, int wc, int fr, int fq) const {
    const int row0 = u.pm * BM + wr * 64 + fr, col0 = u.pn * BM + wc * 32 + 8 * fq;
#pragma unroll
    for (int ai = 0; ai < 2; ++ai) {
      u32x4 rv[4][2];
#pragma unroll
      for (int m = 0; m < 4; ++m)
#pragma unroll
        for (int bj = 0; bj < 2; ++bj) rv[m][bj] = *(const u32x4*)(T + (size_t)(row0 + ai * HALF + m * 16) * D + col0 + bj * HALF);
      asm volatile("" : "+v"(rv[0][0]), "+v"(rv[0][1]), "+v"(rv[1][0]), "+v"(rv[1][1]), "+v"(rv[2][0]), "+v"(rv[2][1]), "+v"(rv[3][0]), "+v"(rv[3][1]));
#pragma unroll
      for (int m = 0; m < 4; ++m)
#pragma unroll
        for (int bj = 0; bj < 2; ++bj)
#pragma unroll
          for (int q = 0; q < 4; ++q) {
            const float r0 = __uint_as_float(rv[m][bj][q] << 16), r1 = __uint_as_float(rv[m][bj][q] & 0xffff0000u);
            if (q < 2) { acc[ai][bj][m][0][2 * q] *= r0; acc[ai][bj][m][0][2 * q + 1] *= r1; }
            else { acc[ai][bj][m][1][2 * q - 4] *= r0; acc[ai][bj][m][1][2 * q - 3] *= r1; }
          }
    }
  }
  __device__ __forceinline__ void operator()(const f32x4 (&acc)[2][2][4][2], const Unit& u, int wr, int wc, int fr, int fq) const {
    const int row0 = u.pm * BM + wr * 64 + fr, col0 = u.pn * BM + wc * 32 + 8 * fq;
#pragma unroll
    for (int ai = 0; ai < 2; ++ai) {
      u32x4 gvv[4][2], tvv[4][2];
#pragma unroll
      for (int m = 0; m < 4; ++m)
#pragma unroll
        for (int bj = 0; bj < 2; ++bj) {
          const size_t ro = (size_t)(row0 + ai * HALF + m * 16) * D + col0 + bj * HALF;
          gvv[m][bj] = *(const u32x4*)(G1 + ro);
          if constexpr (MODE == 1) tvv[m][bj] = *(const u32x4*)(T + ro);
        }
      asm volatile("" : "+v"(gvv[0][0]), "+v"(gvv[0][1]), "+v"(gvv[1][0]), "+v"(gvv[1][1]), "+v"(gvv[2][0]), "+v"(gvv[2][1]), "+v"(gvv[3][0]), "+v"(gvv[3][1]));
#pragma unroll
      for (int m = 0; m < 4; ++m)
#pragma unroll
        for (int bj = 0; bj < 2; ++bj) {
          const size_t ro = (size_t)(row0 + ai * HALF + m * 16) * D + col0 + bj * HALF;
          const u32x4 gv = gvv[m][bj]; u32x4 tv = (u32x4){0u, 0u, 0u, 0u}; if constexpr (MODE == 1) tv = tvv[m][bj];
          const f32x4 v0 = acc[ai][bj][m][0], v1 = acc[ai][bj][m][1];
          const float a8[8] = {v0[0], v0[1], v0[2], v0[3], v1[0], v1[1], v1[2], v1[3]};
          float o[8];
#pragma unroll
          for (int q = 0; q < 4; ++q) {
            const float g0 = __uint_as_float(gv[q] << 16), g1 = __uint_as_float(gv[q] & 0xffff0000u);
            float r0 = g0 * a8[2 * q], r1 = g1 * a8[2 * q + 1];
            if (MODE == 1) { r0 += __uint_as_float(tv[q] << 16); r1 += __uint_as_float(tv[q] & 0xffff0000u); }
            o[2 * q] = r0; o[2 * q + 1] = r1;
          }
          u32x4 w; w.x = cvt_pk_bf16(o[0], o[1]); w.y = cvt_pk_bf16(o[2], o[3]); w.z = cvt_pk_bf16(o[4], o[5]); w.w = cvt_pk_bf16(o[6], o[7]);
          *(u32x4*)(O + ro) = w;
        }
    }
  }
};
struct EpiRes {
  static constexpr bool PERM = true; static constexpr bool BJ32 = false; static constexpr bool HASWT = false;
  const float* x; const float* stats; const float* g; const float* b; float* O;
  __device__ __forceinline__ void operator()(const f32x4 (&acc)[2][2][4][2], const Unit& u, int wr, int wc, int fr, int fq) const {
    const int row0 = u.pm * BM + wr * 64 + fr, col0 = u.pn * BM + wc * 32 + 8 * fq;
    f32x4 gv[2][2], bv[2][2];
#pragma unroll
    for (int bj = 0; bj < 2; ++bj)
#pragma unroll
      for (int n = 0; n < 2; ++n) { gv[bj][n] = *(const f32x4*)(g + col0 + bj * HALF + n * 4) * ALPHA; bv[bj][n] = *(const f32x4*)(b + col0 + bj * HALF + n * 4) * ALPHA; }
#pragma unroll
    for (int ai = 0; ai < 2; ++ai)
#pragma unroll
      for (int m = 0; m < 4; ++m) {
        const int r = row0 + ai * HALF + m * 16; const f32x2 st = *(const f32x2*)(stats + 2 * (size_t)r);
        const size_t ro = (size_t)r * D + col0;
#pragma unroll
        for (int bj = 0; bj < 2; ++bj)
#pragma unroll
          for (int n = 0; n < 2; ++n) {
            const f32x4 xv = *(const f32x4*)(x + ro + bj * HALF + n * 4);
            *(f32x4*)(O + ro + bj * HALF + n * 4) = ((xv - st.x) * st.y) * gv[bj][n] + bv[bj][n] + acc[ai][bj][m][n];
          }
      }
  }
};
struct EpiSwiGLU {
  static constexpr bool PERM = true; static constexpr bool BJ32 = false; static constexpr bool HASWT = false;
  bf16_t* HID;
  __device__ __forceinline__ void operator()(const f32x4 (&acc)[2][2][4][2], const Unit& u, int wr, int wc, int fr, int fq) const {
    const int row0 = u.pm * BM + wr * 64 + fr, col0 = u.pn * 128 + wc * 32 + 8 * fq;
#pragma unroll
    for (int ai = 0; ai < 2; ++ai)
#pragma unroll
      for (int m = 0; m < 4; ++m) {
        float o[8];
#pragma unroll
        for (int n = 0; n < 2; ++n)
#pragma unroll
          for (int j = 0; j < 4; ++j) o[4 * n + j] = silu(acc[ai][0][m][n][j]) * acc[ai][1][m][n][j];
        u32x4 w; w.x = cvt_pk_bf16(o[0], o[1]); w.y = cvt_pk_bf16(o[2], o[3]); w.z = cvt_pk_bf16(o[4], o[5]); w.w = cvt_pk_bf16(o[6], o[7]);
        *(u32x4*)(HID + (size_t)(row0 + ai * HALF + m * 16) * DFF + col0) = w;
      }
  }
};
__device__ __forceinline__ u32x4 ror8(const u32x4 v) {
  u32x4 r;
#pragma unroll
  for (int d = 0; d < 4; ++d) r[d] = (unsigned)__builtin_amdgcn_update_dpp(0, (int)v[d], 0x128, 0xF, 0xF, false);
  return r;
}
template <bool WT> __device__ __forceinline__ void store_rows16_fullline(bf16_t* p, int ld, const u32x4 w0, const u32x4 w1, int fr, int fq) {
  const bool lo = fr < 8;
  u32x4 x, y, a, b;
#pragma unroll
  for (int d = 0; d < 4; ++d) x[d] = lo ? w1[d] : w0[d];
  y = ror8(x);
#pragma unroll
  for (int d = 0; d < 4; ++d) { a[d] = lo ? w0[d] : y[d]; b[d] = lo ? y[d] : w1[d]; }
  bf16_t* q = p + (size_t)(fr & 7) * ld + (fr >> 3) * 32 + 8 * fq;
  if constexpr (WT) { st_wt16(q, a); st_wt16(q + (size_t)8 * ld, b); } else { *(u32x4*)q = a; *(u32x4*)(q + (size_t)8 * ld) = b; }
}
struct EpiBf16 {
  static constexpr bool PERM = true; static constexpr bool BJ32 = true; static constexpr bool HASWT = true;
  bf16_t* O; int ldc;
  template <bool WT> __device__ __forceinline__ void run(const f32x4 (&acc)[2][2][4][2], const Unit& u, int wr, int wc, int fr, int fq) const {
    bf16_t* tile = O + (size_t)(u.pm * BM + wr * 64) * ldc + u.pn * BM + wc * 64;
#pragma unroll
    for (int ai = 0; ai < 2; ++ai)
#pragma unroll
      for (int m = 0; m < 4; ++m) {
        u32x4 w[2];
#pragma unroll
        for (int bj = 0; bj < 2; ++bj) {
          const f32x4 v0 = acc[ai][bj][m][0], v1 = acc[ai][bj][m][1];
          w[bj].x = cvt_pk_bf16(v0[0], v0[1]); w[bj].y = cvt_pk_bf16(v0[2], v0[3]); w[bj].z = cvt_pk_bf16(v1[0], v1[1]); w[bj].w = cvt_pk_bf16(v1[2], v1[3]);
        }
        store_rows16_fullline<WT>(tile + (size_t)(ai * HALF + m * 16) * ldc, ldc, w[0], w[1], fr, fq);
      }
  }
};
}

__device__ __forceinline__ void p0_transpose_item(const float* W, int K, int N, bf16_t* WT, int k0, int n0, int drow0, LAS float* scr, int lane) {
  f32x4 v[8];
#pragma unroll
  for (int i = 0; i < 8; ++i) v[i] = *(const f32x4*)(W + (size_t)(k0 + (lane >> 3) + 8 * i) * N + n0 + (lane & 7) * 4);
#pragma unroll
  for (int i = 0; i < 8; ++i) { LAS float* d = scr + ((lane >> 3) + 8 * i) * 33 + (lane & 7) * 4; d[0] = v[i].x; d[1] = v[i].y; d[2] = v[i].z; d[3] = v[i].w; }
  asm volatile("s_waitcnt lgkmcnt(0)" ::: "memory");
  const int c = lane & 7;
#pragma unroll
  for (int j = 0; j < 4; ++j) { const int n = (lane >> 3) + 8 * j; const LAS float* s = scr + (8 * c) * 33 + n;
    u32x4 o; o.x = pk2(s[0 * 33], s[1 * 33]); o.y = pk2(s[2 * 33], s[3 * 33]); o.z = pk2(s[4 * 33], s[5 * 33]); o.w = pk2(s[6 * 33], s[7 * 33]);
    *(u32x4*)(WT + (size_t)(drow0 + n) * K + k0 + 8 * c) = o; }
  asm volatile("s_waitcnt lgkmcnt(0)" ::: "memory");
}

struct P0Ptrs { const float *w_in, *wpa, *wpb, *w_out, *w_gate, *w_up, *w_down; bf16_t *WT_in, *WT_pa, *WT_pb, *WT_out, *WT_gu, *WT_d; };
__device__ __forceinline__ void p0_decode(const P0Ptrs& P, int it, const float*& src, int& N_, bf16_t*& dst, int& K_) {
  constexpr int I_IN = (D / 64) * (DIN / 32), I_PA = (NAW / 64) * (D / 32), I_OUT = (D / 64) * (D / 32), I_GU = (D / 64) * (DFF / 32), I_DN = (DFF / 64) * (D / 32);
  int r = it;
  if (r < I_IN) { const int nb = DIN / 32, kb = r / nb, n0 = (r % nb) * 32;
    int drow = n0; if (n0 >= 4096) { const int j0 = (n0 - 4096) & 1023; drow = 4096 + (j0 >> 7) * 256 + (n0 >= 5120 ? 128 : 0) + (j0 & 127); }
    src = P.w_in + (size_t)(kb * 64) * DIN + n0; N_ = DIN; dst = P.WT_in + (size_t)drow * D + kb * 64; K_ = D; return; } r -= I_IN;
  if (r < I_PA) { const int nb = D / 32, kb = r / nb, n0 = (r % nb) * 32; src = P.wpa + (size_t)(kb * 64) * D + n0; N_ = D; dst = P.WT_pa + (size_t)n0 * NAW + kb * 64; K_ = NAW; return; } r -= I_PA;
  if (r < I_PA) { const int nb = D / 32, kb = r / nb, n0 = (r % nb) * 32; src = P.wpb + (size_t)(kb * 64) * D + n0; N_ = D; dst = P.WT_pb + (size_t)n0 * HGW + kb * 64; K_ = HGW; return; } r -= I_PA;
  if (r < I_OUT) { const int nb = D / 32, kb = r / nb, n0 = (r % nb) * 32; src = P.w_out + (size_t)(kb * 64) * D + n0; N_ = D; dst = P.WT_out + (size_t)n0 * D + kb * 64; K_ = D; return; } r -= I_OUT;
  const int e = r / (2 * I_GU + I_DN); r -= e * (2 * I_GU + I_DN);
  if (r < 2 * I_GU) {
    const int up = r >= I_GU; if (up) r -= I_GU;
    const int nb = DFF / 32, kb = r / nb, n0 = (r % nb) * 32;
    src = (up ? P.w_up : P.w_gate) + (size_t)e * D * DFF + (size_t)(kb * 64) * DFF + n0; N_ = DFF;
    dst = P.WT_gu + (size_t)(e * 1024 + (n0 >> 7) * 256 + up * 128 + (n0 & 127)) * D + kb * 64; K_ = D;
  } else { r -= 2 * I_GU; const int nb = D / 32, kb = r / nb, n0 = (r % nb) * 32;
    src = P.w_down + (size_t)e * DFF * D + (size_t)(kb * 64) * D + n0; N_ = D; dst = P.WT_d + (size_t)(e * 1024 + n0) * DFF + kb * 64; K_ = DFF; }
}

constexpr int SC_QP = 0;
constexpr int SC_KP = SC_QP + 64 * 272;
constexpr int SC_KT = SC_KP + 64 * 272;
constexpr int SC_VT = SC_KT + 128 * 144;
constexpr int SC_A = SC_VT + 128 * 144;
constexpr int SC_ST = SC_A + 64 * 144;
constexpr int SC_EB = SC_ST + 128 * 272;
constexpr int SC_TOT = SC_EB + 512;
constexpr int SC_END = SC_TOT + 4096;
static_assert(SC_END <= 131072, "scan LDS map");
__device__ __forceinline__ bf16x8 ldfrag(LAS unsigned char* base, int stride, int row, int kel) { return *(const LAS bf16x8*)(base + row * stride + kel * 2); }


#define XB_TMO      128
#define XB_XCNT(j)  (256  + 64 * (j))
#define XB_XSUB(j)  (1280 + 64 * (j))
#define XB_XGEN(j)  (2304 + 64 * (j))
#define XB_TOP      3328
#define XB_TOPGEN   3392
#define XCD_BAR_WORDS 3456
#define XB_SPIN_CAP (1u << 20)
__device__ __forceinline__ unsigned xb_ld(unsigned* p)              { return __hip_atomic_load(p, __ATOMIC_RELAXED, __HIP_MEMORY_SCOPE_AGENT); }
__device__ __forceinline__ unsigned xb_add(unsigned* p, unsigned v) { return __hip_atomic_fetch_add(p, v, __ATOMIC_RELAXED, __HIP_MEMORY_SCOPE_AGENT); }
__device__ __forceinline__ unsigned xb_xcc_id() { return (unsigned)__builtin_amdgcn_s_getreg((3 << 11) | 20) & 0xFu; }
#define XB_SPIN(cond, bar) do { unsigned _sp = 0; while (cond) { __builtin_amdgcn_s_sleep(1); \
    if ((++_sp & 255u) == 0u) { if (xb_ld(&(bar)[XB_TMO])) break; if (_sp > XB_SPIN_CAP) { atomicAdd(&(bar)[XB_TMO], 1u); break; } } } } while (0)
struct XcdBarrier { unsigned* bar; unsigned x; volatile LAS unsigned* st; };
__device__ __forceinline__ XcdBarrier xcd_barrier_post(unsigned* bar, volatile LAS unsigned* st) {
  XcdBarrier b; b.bar = bar; b.x = xb_xcc_id(); b.st = st;
  if (threadIdx.x == 0) (void)xb_add(&bar[XB_XCNT(b.x)], 1u);
  return b;
}
__device__ __forceinline__ void xcd_barrier_complete(unsigned* bar, unsigned x, unsigned& nloc, unsigned& nx) {
  const unsigned G = gridDim.x * gridDim.y * gridDim.z;
  unsigned sum, cnt, mine, sp = 0u;
  for (;;) {
    sum = 0u; cnt = 0u; mine = 0u;
#pragma unroll
    for (unsigned j = 0; j < 16; ++j) { const unsigned c = xb_ld(&bar[XB_XCNT(j)]); sum += c; cnt += (c > 0u) ? 1u : 0u; mine = (j == x) ? c : mine; }
    if (sum == G) break;
    __builtin_amdgcn_s_sleep(1);
    if ((++sp & 255u) == 0u) { if (xb_ld(&bar[XB_TMO])) break; if (sp > XB_SPIN_CAP) { atomicAdd(&bar[XB_TMO], 1u); break; } }
  }
  nloc = mine > 0u ? mine : 1u; nx = cnt > 0u ? cnt : 1u;
}
__device__ __forceinline__ void xcd_barrier(const XcdBarrier& b) {
  asm volatile("s_waitcnt vmcnt(0)" ::: "memory");
  __syncthreads();
  if (threadIdx.x == 0) {
    unsigned* bar = b.bar;
    __builtin_amdgcn_s_waitcnt(0);
    unsigned nloc = b.st[0], nx = b.st[1];
    if (nloc == 0u) { xcd_barrier_complete(bar, b.x, nloc, nx); b.st[0] = nloc; b.st[1] = nx; }
    const unsigned old = xb_add(&bar[XB_XSUB(b.x)], 1u);
    const unsigned gen = old / nloc;
    if (old + 1u == (gen + 1u) * nloc) {
      __builtin_amdgcn_fence(__ATOMIC_RELEASE, "agent");
      asm volatile("s_waitcnt vmcnt(0)" ::: "memory");
      (void)xb_add(&bar[XB_TOP], 1u);
    }
    XB_SPIN(xb_ld(&bar[XB_TOP]) < (gen + 1u) * nx, bar);
    __builtin_amdgcn_fence(__ATOMIC_ACQUIRE, "agent");
    asm volatile("s_waitcnt vmcnt(0)" ::: "memory");
  }
  __syncthreads();
}

constexpr int LDS_BYTES = 157696;
__global__ void __launch_bounds__(NT, 2) fwd_megakernel(Params p) {
  cg::grid_group grid = cg::this_grid();
  extern __shared__ __attribute__((aligned(16))) unsigned char lds_raw[];
  LAS unsigned char* lds = (LAS unsigned char*)lds_raw;
  const int G = gridDim.x, bid = blockIdx.x, NGW = G * (NT / 64);
  volatile LAS unsigned* bst = (volatile LAS unsigned*)(lds + LDS_BYTES - 16);
  if (threadIdx.x < 4) bst[threadIdx.x] = 0u;
  __syncthreads();
  if (bid == 0) for (int i = threadIdx.x; i < 4096; i += NT) __hip_atomic_store((unsigned*)(p.ws + WS_BAR) + i, 0u, __ATOMIC_RELAXED, __HIP_MEMORY_SCOPE_AGENT);
#define GRID_BAR() xcd_barrier(xbar)
#define PHASE_IDS const int tid = opq(threadIdx.x), lane = tid & 63, wid = tid >> 6, gw = bid * (NT / 64) + wid; (void)lane; (void)gw; (void)wid;

  const float* x = p.in[0];
  const float *emb_g = p.in[1], *emb_b = p.in[2], *w_in = p.in[3], *rpb = p.in[4], *hg_lb = p.in[5], *hg_ng = p.in[6];
  const float *wpa = p.in[7], *wpb = p.in[8], *w_out = p.in[9], *ln1_g = p.in[10], *ln1_b = p.in[11];
  const float *w_rg = p.in[12], *b_rg = p.in[13], *w_re = p.in[14], *b_re = p.in[15];
  const float *w_gate = p.in[16], *w_up = p.in[17], *w_down = p.in[18], *ln2_g = p.in[19], *ln2_b = p.in[20];
  unsigned char* ws = p.ws;
  int* cnt = (int*)(ws + WS_CTRL); int* offs = (int*)(ws + WS_CTRL + 256); int* nmt_p = (int*)(ws + WS_CTRL + 512); int* tile_e = (int*)(ws + WS_CTRL + 1024);
  float* lb = (float*)(ws + WS_CTRL + 8192); int* blk_base = (int*)(ws + WS_CTRL + 32768);
  bf16_t* WT_in = (bf16_t*)(ws + WS_WT_IN); bf16_t* WT_pa = (bf16_t*)(ws + WS_WT_PA); bf16_t* WT_pb = (bf16_t*)(ws + WS_WT_PB); bf16_t* WT_out = (bf16_t*)(ws + WS_WT_OUT);
  bf16_t* WT_gu = (bf16_t*)(ws + WS_WT_GU); bf16_t* WT_d = (bf16_t*)(ws + WS_WT_D);
  bf16_t* hb = (bf16_t*)(ws + WS_HB); bf16_t* hid = (bf16_t*)(ws + WS_HID);
  bf16_t* a_na = (bf16_t*)((unsigned char*)p.out + 128 * MiB); bf16_t* c_hg = (bf16_t*)((unsigned char*)p.out + 192 * MiB);
  bf16_t* NAQ = (bf16_t*)(ws + WS_NAQ); bf16_t* NAK = (bf16_t*)(ws + WS_NAK); bf16_t* NAV = (bf16_t*)(ws + WS_NAV); bf16_t* HQ = (bf16_t*)(ws + WS_HQ);
  bf16_t* GF = (bf16_t*)(ws + WS_GF); bf16_t* GBW = (bf16_t*)(ws + WS_GB); bf16_t* HI = (bf16_t*)(ws + WS_HI); bf16_t* HG = (bf16_t*)(ws + WS_HG);
  bf16_t* GA = (bf16_t*)(ws + WS_GA); bf16_t* GBT = (bf16_t*)(ws + WS_GBT);
  int* srt = (int*)(ws + WS_XG);
  bf16_t* T1 = (bf16_t*)(ws + WS_T1); bf16_t* merged = (bf16_t*)(ws + WS_MERGED); bf16_t* h1b = (bf16_t*)(ws + WS_H1B); bf16_t* xg = (bf16_t*)(ws + WS_XG); bf16_t* ybuf = (bf16_t*)(ws + WS_Y);
  int* tok_e = (int*)(ws + WS_TOKE); int* tok_p = (int*)(ws + WS_TOKP); float* tok_w = (float*)(ws + WS_TOKW);
  float* Sloc = (float*)c_hg;
  float* Dtot = (float*)((unsigned char*)c_hg + 16 * MiB);
  bf16_t* obf = (bf16_t*)p.out; bf16_t* obb = (bf16_t*)p.out + (size_t)NTOK * HGW; float* h1 = p.out;

  { PHASE_IDS
    if (bid == 0 && tid < NE) cnt[tid] = 0;
    for (int i = bid * NT + tid; i < 2 * HGW; i += G * NT) {
      const int dir = i / HGW, c = i % HGW;
      const float v0 = hg_lb[dir * 2 * HGW + c], v1 = hg_lb[dir * 2 * HGW + HGW + c];
      const float m = fmaxf(v0, v1), e0 = expf(v0 - m), e1 = expf(v1 - m);
      lb[i] = e0 / (e0 + e1);
    }
    LAS float* scr = (LAS float*)(lds + wid * 16384);
    constexpr int I_IN = (D / 64) * (DIN / 32), I_PA = (NAW / 64) * (D / 32), I_OUT = (D / 64) * (D / 32), I_GU = (D / 64) * (DFF / 32), I_DN = (DFF / 64) * (D / 32);
    constexpr int NITEMS = I_IN + 2 * I_PA + I_OUT + NE * (2 * I_GU + I_DN);
    {
      const P0Ptrs PP{w_in, wpa, wpb, w_out, w_gate, w_up, w_down, WT_in, WT_pa, WT_pb, WT_out, WT_gu, WT_d};
      f32x4 gq4[4], bq4[4];
#pragma unroll
      for (int j = 0; j < 4; ++j) { gq4[j] = ((const f32x4*)emb_g)[lane + 64 * j]; bq4[j] = ((const f32x4*)emb_b)[lane + 64 * j]; }
      f32x4 xn[2][4], wn[8]; bf16_t* dstn = nullptr; int Kn_ = 0;
#define P0_LOADX(t_) do { const f32x4* xr_ = (const f32x4*)(x + (size_t)(t_) * D) + lane; \
        _Pragma("unroll") for (int rr = 0; rr < 2; ++rr) _Pragma("unroll") for (int j = 0; j < 4; ++j) xn[rr][j] = __builtin_nontemporal_load(xr_ + rr * (D / 4) + 64 * j); } while (0)
#define P0_LOADW(it_) do { const float* src_; int N_; p0_decode(PP, (it_), src_, N_, dstn, Kn_); \
        _Pragma("unroll") for (int i = 0; i < 8; ++i) wn[i] = __builtin_nontemporal_load((const f32x4*)(src_ + (size_t)((lane >> 3) + 8 * i) * N_ + (lane & 7) * 4)); } while (0)
      constexpr int NSTEP = NTOK / 2 / 2048;
      P0_LOADX(2 * gw); if (gw < NITEMS) P0_LOADW(gw);
#pragma unroll 1
      for (int k = 0; k < NSTEP; ++k) {
        const int t = 2 * gw + k * 2 * NGW, it = gw + k * NGW;
        f32x4 v[2][4], wv[8]; bf16_t* dst = dstn; const int K_ = Kn_;
#pragma unroll
        for (int rr = 0; rr < 2; ++rr)
#pragma unroll
          for (int j = 0; j < 4; ++j) v[rr][j] = xn[rr][j];
#pragma unroll
        for (int i = 0; i < 8; ++i) wv[i] = wn[i];
        if (k + 1 < NSTEP) { P0_LOADX(t + 2 * NGW); if (it + NGW < NITEMS) P0_LOADW(it + NGW); }
        float s0 = 0.f, s1 = 0.f;
#pragma unroll
        for (int j = 0; j < 4; ++j) { s0 += (v[0][j].x + v[0][j].y) + (v[0][j].z + v[0][j].w); s1 += (v[1][j].x + v[1][j].y) + (v[1][j].z + v[1][j].w); }
        const float mean0 = wave_sum(s0) * (1.f / D), mean1 = wave_sum(s1) * (1.f / D);
        float q0 = 0.f, q1 = 0.f;
#pragma unroll
        for (int j = 0; j < 4; ++j) { v[0][j] = v[0][j] - mean0; v[1][j] = v[1][j] - mean1;
          q0 += (v[0][j].x * v[0][j].x + v[0][j].y * v[0][j].y) + (v[0][j].z * v[0][j].z + v[0][j].w * v[0][j].w);
          q1 += (v[1][j].x * v[1][j].x + v[1][j].y * v[1][j].y) + (v[1][j].z * v[1][j].z + v[1][j].w * v[1][j].w); }
        const float rstd0 = rsqrtf(wave_sum(q0) * (1.f / D) + LN_EPS), rstd1 = rsqrtf(wave_sum(q1) * (1.f / D) + LN_EPS);
        u32x2* o8 = (u32x2*)(hb + (size_t)t * D) + lane;
#pragma unroll
        for (int j = 0; j < 4; ++j) {
          const f32x4 oa = v[0][j] * rstd0 * gq4[j] + bq4[j], ob_ = v[1][j] * rstd1 * gq4[j] + bq4[j];
          u32x2 wa; wa.x = cvt_pk_bf16(oa.x, oa.y); wa.y = cvt_pk_bf16(oa.z, oa.w); st_wt8(o8 + 64 * j, wa);
          u32x2 wb; wb.x = cvt_pk_bf16(ob_.x, ob_.y); wb.y = cvt_pk_bf16(ob_.z, ob_.w); st_wt8(o8 + D / 4 + 64 * j, wb);
        }
        if (it < NITEMS) {
#pragma unroll
          for (int i = 0; i < 8; ++i) { LAS float* d = scr + ((lane >> 3) + 8 * i) * 33 + (lane & 7) * 4; d[0] = wv[i].x; d[1] = wv[i].y; d[2] = wv[i].z; d[3] = wv[i].w; }
          asm volatile("s_waitcnt lgkmcnt(0)" ::: "memory");
          const int c = lane & 7;
#pragma unroll
          for (int j = 0; j < 4; ++j) { const int n = (lane >> 3) + 8 * j; const LAS float* sp = scr + (8 * c) * 33 + n;
            u32x4 o; o.x = cvt_pk_bf16(sp[0 * 33], sp[1 * 33]); o.y = cvt_pk_bf16(sp[2 * 33], sp[3 * 33]); o.z = cvt_pk_bf16(sp[4 * 33], sp[5 * 33]); o.w = cvt_pk_bf16(sp[6 * 33], sp[7 * 33]);
            *(u32x4*)(dst + (size_t)n * K_ + 8 * c) = o; }
          asm volatile("s_waitcnt lgkmcnt(0)" ::: "memory");
        }
      }
#undef P0_LOADX
#undef P0_LOADW
    }
  }
  grid.sync();
  XcdBarrier xbar = xcd_barrier_post((unsigned*)(p.ws + WS_BAR), bst);
  {
    pg8::Gemm g{hb, WT_in, D, 0}; pg8::StaticOrder S; S.init(NTOK, DIN, G, bid, false, 4);
    { LAS float* lbl = (LAS float*)(lds + 131072 + 4096); static_assert(2 * HGW == 2 * NT, "lb copy"); const float l0_ = lb[threadIdx.x], l1_ = lb[threadIdx.x + NT]; lbl[threadIdx.x] = l0_; lbl[threadIdx.x + NT] = l1_; __syncthreads(); }
    pg8::EpiU E{ws + WS_U0, lds + 131072 + 8192, (const LAS float*)(lds + 131072 + 4096)};
    pg8::gemm_phase(lds, g, S, E);
  }
  GRID_BAR();
  { PHASE_IDS
    const int w = __builtin_amdgcn_readfirstlane(wid);
    const int seq = bid >> 2, sg = bid & 3, b = seq >> 3, dir = (seq >> 2) & 1, head = seq & 3;
    const bf16_t* Gp = dir ? GBW : GF; bf16_t* ob = dir ? obb : obf;
    const size_t t0 = (size_t)b * SEQ;
    const int hh = lane >> 5, r = lane & 31;
    constexpr float LOG2E = 1.4426950408889634f;
    for (int i = tid; i < 128 * 272 / 4; i += NT) ((LAS unsigned*)(lds + SC_ST))[i] = 0u;
    f32x16 s0, s1, oacc;
#pragma unroll
    for (int i = 0; i < 16; ++i) { s0[i] = 0.f; s1[i] = 0.f; }
    const int kbS = w >> 1, vbS = 2 * (w & 1), ibO = w >> 2, vbO = w & 3;
    float bsum0 = 0.f, bsum1 = 0.f;
    unsigned gq[8], gg[8]; u32x4 gv0, gv1;
    const int vrow = tid >> 2, vpart = tid & 3;
    const int coff = head * HGD + 2 * lane;
    const bf16_t* VTg = HI + (size_t)((b * 4 + head) * 128) * 128 * 64;
#define SC_TOK(c_, i_) (dir ? (SEQ - 1 - ((c_) * 64 + (i_))) : ((c_) * 64 + (i_)))
#define SC_LOAD(c_, Q_, G_, V0_, V1_) do { const size_t tb_ = (t0 + SC_TOK(c_, 8 * w)) * HGW + coff; const bf16_t* qb_ = HQ + tb_; const bf16_t* gb_ = Gp + tb_; \
      if (dir) { _Pragma("unroll") for (int e = 0; e < 8; ++e) { Q_[e] = *(const unsigned*)(qb_ - e * HGW); G_[e] = *(const unsigned*)(gb_ - e * HGW); } } \
      else { _Pragma("unroll") for (int e = 0; e < 8; ++e) { Q_[e] = *(const unsigned*)(qb_ + e * HGW); G_[e] = *(const unsigned*)(gb_ + e * HGW); } } \
      { const bf16_t* vp_ = VTg + ((size_t)((dir ? 127 - (c_) : (c_)) * 128 + vrow)) * 64 + vpart * 16; V0_ = *(const u32x4*)vp_; V1_ = *(const u32x4*)(vp_ + 8); } } while (0)
    unsigned gqB[8], ggB[8]; u32x4 gv0B, gv1B;
    SC_LOAD(32 * sg, gq, gg, gv0, gv1); SC_LOAD(32 * sg + 1, gqB, ggB, gv0B, gv1B);
    auto sc_chunk = [&](const int c, unsigned (&Q_)[8], unsigned (&G_)[8], u32x4& V0_, u32x4& V1_) __attribute__((always_inline)) {
      const int cg_ = 32 * sg + c;
      float c0[8], c1[8], l0[8], l1[8];
      {
        float a0 = 0.f, a1 = 0.f;
#pragma unroll
        for (int e = 0; e < 8; ++e) {
          l0[e] = h2f((unsigned short)(G_[e] & 0xffffu)) * LOG2E; l1[e] = h2f((unsigned short)(G_[e] >> 16)) * LOG2E;
          a0 += l0[e]; a1 += l1[e]; c0[e] = a0; c1[e] = a1;
        }
        *(LAS f32x2*)(lds + SC_TOT + (w * 128 + 2 * lane) * 4) = (f32x2){a0, a1};
      }
      __syncthreads();
      float off0 = 0.f, off1 = 0.f, bl0 = 0.f, bl1 = 0.f;
#pragma unroll
      for (int w2 = 0; w2 < 8; ++w2) {
        const f32x2 tv = *(const LAS f32x2*)(lds + SC_TOT + (w2 * 128 + 2 * lane) * 4);
        bl0 += tv.x; bl1 += tv.y; if (w2 < w) { off0 += tv.x; off1 += tv.y; }
      }
      bsum0 += bl0; bsum1 += bl1;
      const float eb0 = __builtin_amdgcn_exp2f(bl0), eb1 = __builtin_amdgcn_exp2f(bl1);
      if (w == 0) *(LAS f32x2*)(lds + SC_EB + 2 * lane * 4) = (f32x2){eb0, eb1};
      {
        float kp0[8], kp1[8];
#pragma unroll
        for (int e = 0; e < 8; ++e) {
          const float B0 = off0 + c0[e], B1 = off1 + c1[e];
          const float q0 = __uint_as_float(Q_[e] << 16), q1 = __uint_as_float(Q_[e] & 0xffff0000u);
          const float k0 = 1.f - __builtin_amdgcn_exp2f(l0[e]), k1 = 1.f - __builtin_amdgcn_exp2f(l1[e]);
          const float e0 = __builtin_amdgcn_exp2f(B0), e1 = __builtin_amdgcn_exp2f(B1);
          const float qp0 = q0 * e0, qp1 = q1 * e1;
          const float kq0 = k0 * __builtin_amdgcn_rcpf(e0), kq1 = k1 * __builtin_amdgcn_rcpf(e1);
          kp0[e] = kq0 * eb0; kp1[e] = kq1 * eb1;
          const int i = 8 * w + e;
          *(LAS unsigned*)(lds + SC_QP + i * 272 + lane * 4) = cvt_pk_bf16(qp0, qp1);
          *(LAS unsigned*)(lds + SC_KP + i * 272 + lane * 4) = cvt_pk_bf16(kq0, kq1);
        }
        const int kto = dir ? (56 - 8 * w) * 2 : 16 * w;
        u32x4 t;
        if (dir) { t.x = cvt_pk_bf16(kp0[7], kp0[6]); t.y = cvt_pk_bf16(kp0[5], kp0[4]); t.z = cvt_pk_bf16(kp0[3], kp0[2]); t.w = cvt_pk_bf16(kp0[1], kp0[0]); }
        else { t.x = cvt_pk_bf16(kp0[0], kp0[1]); t.y = cvt_pk_bf16(kp0[2], kp0[3]); t.z = cvt_pk_bf16(kp0[4], kp0[5]); t.w = cvt_pk_bf16(kp0[6], kp0[7]); }
        *(LAS u32x4*)(lds + SC_KT + (2 * lane) * 144 + kto) = t;
        if (dir) { t.x = cvt_pk_bf16(kp1[7], kp1[6]); t.y = cvt_pk_bf16(kp1[5], kp1[4]); t.z = cvt_pk_bf16(kp1[3], kp1[2]); t.w = cvt_pk_bf16(kp1[1], kp1[0]); }
        else { t.x = cvt_pk_bf16(kp1[0], kp1[1]); t.y = cvt_pk_bf16(kp1[2], kp1[3]); t.z = cvt_pk_bf16(kp1[4], kp1[5]); t.w = cvt_pk_bf16(kp1[6], kp1[7]); }
        *(LAS u32x4*)(lds + SC_KT + (2 * lane + 1) * 144 + kto) = t;
        *(LAS u32x4*)(lds + SC_VT + vrow * 144 + vpart * 32) = V0_;
        *(LAS u32x4*)(lds + SC_VT + vrow * 144 + vpart * 32 + 16) = V1_;
      }
      __syncthreads();
      { const int c2_ = (c + 2 < 32) ? cg_ + 2 : cg_; SC_LOAD(c2_, Q_, G_, V0_, V1_); }
      {
#pragma unroll
        for (int g = 0; g < 4; ++g) { const f32x4 eb = *(const LAS f32x4*)(lds + SC_EB + (kbS * 32 + 8 * g + 4 * hh) * 4);
          s0[4 * g] *= eb[0]; s0[4 * g + 1] *= eb[1]; s0[4 * g + 2] *= eb[2]; s0[4 * g + 3] *= eb[3];
          s1[4 * g] *= eb[0]; s1[4 * g + 1] *= eb[1]; s1[4 * g + 2] *= eb[2]; s1[4 * g + 3] *= eb[3]; }
        bf16x8 fk[4], fv0[4], fv1[4];
#pragma unroll
        for (int st = 0; st < 4; ++st) { fk[st] = ldfrag(lds + SC_KT, 144, kbS * 32 + r, 8 * hh + 16 * st); fv0[st] = ldfrag(lds + SC_VT, 144, vbS * 32 + r, 8 * hh + 16 * st); fv1[st] = ldfrag(lds + SC_VT, 144, vbS * 32 + 32 + r, 8 * hh + 16 * st); }
        __builtin_amdgcn_sched_barrier(0);
#pragma unroll
        for (int st = 0; st < 4; ++st) { s0 = MFMA32(fk[st], fv0[st], s0); s1 = MFMA32(fk[st], fv1[st], s1); }
      }
      if (w >= 5) {
        const int jb = (w == 7), ib = (w >= 6);
        f32x16 x;
#pragma unroll
        for (int i = 0; i < 16; ++i) x[i] = 0.f;
        { bf16x8 fa[8], fb[8];
#pragma unroll
          for (int st = 0; st < 8; ++st) { fa[st] = ldfrag(lds + SC_KP, 272, jb * 32 + r, 8 * hh + 16 * st); fb[st] = ldfrag(lds + SC_QP, 272, ib * 32 + r, 8 * hh + 16 * st); }
          __builtin_amdgcn_sched_barrier(0);
#pragma unroll
          for (int st = 0; st < 8; ++st) x = MFMA32(fa[st], fb[st], x); }
        const int ii = ib * 32 + r;
#pragma unroll
        for (int g = 0; g < 4; ++g) {
          const int j0 = jb * 32 + 8 * g + 4 * hh;
          const float x0 = (j0 + 0 <= ii) ? x[4 * g] : 0.f, x1 = (j0 + 1 <= ii) ? x[4 * g + 1] : 0.f, x2 = (j0 + 2 <= ii) ? x[4 * g + 2] : 0.f, x3 = (j0 + 3 <= ii) ? x[4 * g + 3] : 0.f;
          u32x2 pk;
          if (dir) { pk.x = cvt_pk_bf16(x3, x2); pk.y = cvt_pk_bf16(x1, x0); *(LAS u32x2*)(lds + SC_A + ii * 144 + (60 - j0) * 2) = pk; }
          else { pk.x = cvt_pk_bf16(x0, x1); pk.y = cvt_pk_bf16(x2, x3); *(LAS u32x2*)(lds + SC_A + ii * 144 + j0 * 2) = pk; }
        }
      }
      {
#pragma unroll
        for (int i = 0; i < 16; ++i) oacc[i] = 0.f;
        bf16x8 fa[8], fb[8];
#pragma unroll
        for (int st = 0; st < 8; ++st) { fa[st] = ldfrag(lds + SC_QP, 272, ibO * 32 + r, 8 * hh + 16 * st); fb[st] = ldfrag(lds + SC_ST, 272, vbO * 32 + r, 8 * hh + 16 * st); }
        __builtin_amdgcn_sched_barrier(0);
#pragma unroll
        for (int st = 0; st < 8; ++st) oacc = MFMA32(fa[st], fb[st], oacc);
      }
      __syncthreads();
      {
        const int st0 = (ibO == 0 && dir) ? 2 : 0, st1 = (ibO == 0 && !dir) ? 2 : 4;
        { bf16x8 fa[4], fb[4];
#pragma unroll
          for (int st = 0; st < 4; ++st) { fa[st] = ldfrag(lds + SC_A, 144, ibO * 32 + r, 8 * hh + 16 * st); fb[st] = ldfrag(lds + SC_VT, 144, vbO * 32 + r, 8 * hh + 16 * st); }
          __builtin_amdgcn_sched_barrier(0);
#pragma unroll
          for (int st = 0; st < 4; ++st) if (st >= st0 && st < st1) oacc = MFMA32(fa[st], fb[st], oacc); }
        {
          bf16_t* ob0 = ob + (t0 + SC_TOK(cg_, ibO * 32 + 4 * hh)) * HGW + head * HGD + vbO * 32 + r;
          if (dir) {
#pragma unroll
            for (int rg = 0; rg < 16; ++rg) ob0[-((rg & 3) + 8 * (rg >> 2)) * HGW] = __builtin_bit_cast(unsigned short, (__bf16)oacc[rg]);
          } else {
#pragma unroll
            for (int rg = 0; rg < 16; ++rg) ob0[((rg & 3) + 8 * (rg >> 2)) * HGW] = __builtin_bit_cast(unsigned short, (__bf16)oacc[rg]);
          }
        }
#pragma unroll
        for (int g = 0; g < 4; ++g) {
          u32x2 pk; pk.x = cvt_pk_bf16(s0[4 * g], s0[4 * g + 1]); pk.y = cvt_pk_bf16(s0[4 * g + 2], s0[4 * g + 3]);
          *(LAS u32x2*)(lds + SC_ST + (vbS * 32 + r) * 272 + (kbS * 32 + 8 * g + 4 * hh) * 2) = pk;
          pk.x = cvt_pk_bf16(s1[4 * g], s1[4 * g + 1]); pk.y = cvt_pk_bf16(s1[4 * g + 2], s1[4 * g + 3]);
          *(LAS u32x2*)(lds + SC_ST + (vbS * 32 + 32 + r) * 272 + (kbS * 32 + 8 * g + 4 * hh) * 2) = pk;
        }
      }
      __syncthreads();
    };
    for (int c = 0; c < 32; c += 2) { sc_chunk(c, gq, gg, gv0, gv1); sc_chunk(c + 1, gqB, ggB, gv0B, gv1B); }
    {
      float* sl = Sloc + (size_t)(seq * 4 + sg) * 128 * 128;
#pragma unroll
      for (int rg = 0; rg < 16; ++rg) { const int k = kbS * 32 + (rg & 3) + 8 * (rg >> 2) + 4 * hh;
        sl[k * 128 + vbS * 32 + r] = s0[rg]; sl[k * 128 + vbS * 32 + 32 + r] = s1[rg]; }
      if (w == 0) *(f32x2*)(Dtot + (size_t)(seq * 4 + sg) * 128 + 2 * lane) = (f32x2){bsum0, bsum1};
    }
  }
  { PHASE_IDS
    constexpr float LOG2E = 1.4426950408889634f;
    constexpr int NA_TB = 131072;
    const int bh = (bid & 7) * 8 + (bid >> 5), b = bh >> 3, head = bh & 7, rq = (bid >> 3) & 3;
    LAS float* Tb = (LAS float*)(lds + NA_TB);
    {
      float tv[4];
#pragma unroll
      for (int k = 0; k < 4; ++k) { const int idx = tid + k * NT, dr = idx >> 7, xx = (idx & 127) - 48; tv[k] = (idx < 15 * 128 && xx >= 0 && xx <= 30) ? rpb[(head * 15 + dr) * 31 + xx] * LOG2E : 0.f; }
#pragma unroll
      for (int k = 0; k < 4; ++k) { const int idx = tid + k * NT; if (idx < 15 * 128) Tb[idx] = tv[k]; }
    }
    const int w = __builtin_amdgcn_readfirstlane(wid), qb = w & 1, hh = lane >> 5, ql = lane & 31, c = 32 * qb + ql;
    int cs = c - KW / 2; cs = cs < 0 ? 0 : (cs > GW - KW ? GW - KW : cs);
    float cm[3][2][4];
#pragma unroll
    for (int cbi = 0; cbi < 3; ++cbi)
#pragma unroll
      for (int g1 = 0; g1 < 2; ++g1)
#pragma unroll
        for (int jj = 0; jj < 4; ++jj) { const int kc = 16 * (qb + cbi) + 8 * hh + 4 * g1 + jj; cm[cbi][g1][jj] = (kc >= cs && kc < cs + KW) ? 0.f : -1.0e30f; }
    const int lbase = NA_TB + ((63 - c) + 8 * hh + 16 * qb) * 4;
    const int colperm = 8 * ((ql >> 2) & 1) + 4 * ((ql >> 3) & 1) + (ql & 3);
    const int koff = (hh * 64 + 16 * qb + colperm) * 16;
    const int voff = 8192 + ((2 * qb + hh) * 64 + ql) * 16;
    const bf16_t* Krows = NAK + (size_t)((b * 8 + head) * 128) * 4096 + tid * 8;
    const bf16_t* Vrows = NAV + (size_t)((b * 8 + head) * 128) * 4096 + tid * 8;
#define NA_RS(r_) ((r_) - KH / 2 < 0 ? 0 : ((r_) - KH / 2 > ROWS - KH ? ROWS - KH : (r_) - KH / 2))
    bf16x8 Qn[4];
#define NA_QLD(u_) do { const size_t tq_ = (size_t)b * SEQ + (32 * rq + 4 * (u_) + (w >> 1)) * GW + c; \
      _Pragma("unroll") for (int st = 0; st < 4; ++st) Qn[st] = *(const bf16x8*)(NAQ + tq_ * NAW + head * NADH + 16 * st + 8 * hh); } while (0)
    NA_QLD(0);
    unsigned wt0, wt1, wt2, wt3;
    {
      const int rlo = NA_RS(32 * rq), rhi = NA_RS(32 * rq + 31) + 7;
      const int n1 = (rhi - rlo + 1) * 2, i1 = tid < n1 ? tid : 0;
      wt0 = *(const unsigned*)(NAK + (size_t)((b * 8 + head) * 128 + rlo) * 4096 + (size_t)i1 * 2048);
      wt1 = *(const unsigned*)(NAV + (size_t)((b * 8 + head) * 128 + rlo) * 4096 + (size_t)i1 * 2048);
      static_assert(32 * 64 / 4 == NT, "NA warm-up");
      const size_t tk = (size_t)b * SEQ + (32 * rq) * GW + 4 * tid;
      wt2 = *(const unsigned*)(NAQ + tk * NAW + head * NADH);
      wt3 = *(const unsigned*)(a_na + tk * NAW + head * NADH);
    }
    int hi;
    {
      const int r0 = 32 * rq; const int lo = NA_RS(r0); hi = NA_RS(r0 + 3) + 1;
      u32x4 kv[5], vv[5];
#pragma unroll
      for (int k = 0; k < 5; ++k) { const int row = (lo + k <= hi) ? lo + k : hi; kv[k] = __builtin_nontemporal_load((const u32x4*)(Krows + (size_t)row * 4096)); vv[k] = __builtin_nontemporal_load((const u32x4*)(Vrows + (size_t)row * 4096)); }
#pragma unroll
      for (int k = 0; k < 5; ++k) { const int row = (lo + k <= hi) ? lo + k : hi;
        *(LAS u32x4*)(lds + (row & 7) * 16384 + tid * 16) = kv[k]; *(LAS u32x4*)(lds + (row & 7) * 16384 + 8192 + tid * 16) = vv[k]; }
    }
    asm volatile("" :: "v"(wt0), "v"(wt1), "v"(wt2), "v"(wt3));
#define NA_NEED(k_) ((k_) >= 32 ? ROWS - 1 : (NA_RS(32 * rq + 4 * ((k_) >> 2) + 3) + 2 * ((k_) & 3) + 1 > ROWS - 1 ? ROWS - 1 : NA_RS(32 * rq + 4 * ((k_) >> 2) + 3) + 2 * ((k_) & 3) + 1))
    u32x4 pkO0, pvO0, pkO1, pvO1; int nO;
    { int t1 = NA_NEED(1); t1 = t1 < hi ? hi : t1; nO = t1 - hi;
      if (nO >= 1) { pkO0 = __builtin_nontemporal_load((const u32x4*)(Krows + (size_t)(hi + 1) * 4096)); pvO0 = __builtin_nontemporal_load((const u32x4*)(Vrows + (size_t)(hi + 1) * 4096)); }
      if (nO >= 2) { pkO1 = __builtin_nontemporal_load((const u32x4*)(Krows + (size_t)(hi + 2) * 4096)); pvO1 = __builtin_nontemporal_load((const u32x4*)(Vrows + (size_t)(hi + 2) * 4096)); } }
#pragma unroll 1
    for (int u = 0; u < 8; ++u) {
      const int r0u = 32 * rq + 4 * u, r = r0u + (w >> 1);
      const int rs = NA_RS(r), dr0 = rs - r + 7;
      const size_t tokQ = (size_t)b * SEQ + r * GW + c;
      bf16x8 Qf[4];
#pragma unroll
      for (int st = 0; st < 4; ++st) Qf[st] = Qn[st];
      asm volatile("" : "+v"(Qf[0]), "+v"(Qf[1]), "+v"(Qf[2]), "+v"(Qf[3]));
      NA_QLD(u < 7 ? u + 1 : u);
      float mx = -1.0e30f, lsum = 0.f; f32x16 o0, o1;
#pragma unroll
      for (int i = 0; i < 16; ++i) { o0[i] = 0.f; o1[i] = 0.f; }
#pragma unroll 1
      for (int i2 = 0; i2 < 4; ++i2) {
        __syncthreads();
        const int kstep_ = 4 * u + i2, req = hi + nO;
        int tgt = (kstep_ + 2 < 32) ? NA_NEED(kstep_ + 2) : req; tgt = tgt < req ? req : tgt;
        const int nN = tgt - req;
        u32x4 pkN0, pvN0, pkN1, pvN1;
        if (nN >= 1) { pkN0 = __builtin_nontemporal_load((const u32x4*)(Krows + (size_t)(req + 1) * 4096)); pvN0 = __builtin_nontemporal_load((const u32x4*)(Vrows + (size_t)(req + 1) * 4096)); }
        if (nN >= 2) { pkN1 = __builtin_nontemporal_load((const u32x4*)(Krows + (size_t)(req + 2) * 4096)); pvN1 = __builtin_nontemporal_load((const u32x4*)(Vrows + (size_t)(req + 2) * 4096)); }
        const int tbo = lbase + (dr0 + 2 * i2) * 512;
        const int kslot = ((rs + 2 * i2 + (ql >> 4)) & 7) * 16384 + koff;
        const int vslot0 = ((rs + 2 * i2) & 7) * 16384 + voff, vslot1 = ((rs + 2 * i2 + 1) & 7) * 16384 + voff;
#pragma unroll
        for (int cbi = 0; cbi < 3; ++cbi) {
          f32x16 acc;
#pragma unroll
          for (int rg = 0; rg < 16; ++rg) { const int gg = rg >> 2, jj = rg & 3;
            acc[rg] = *(const LAS float*)(lds + tbo + (gg >> 1) * 512 + (16 * cbi + 4 * (gg & 1) + jj) * 4) + cm[cbi][gg & 1][jj]; }
          {
            bf16x8 kf[4];
#pragma unroll
            for (int st = 0; st < 4; ++st) kf[st] = *(const LAS bf16x8*)(lds + kslot + (2 * st * 64 + 16 * cbi) * 16);
            __builtin_amdgcn_sched_barrier(0);
#pragma unroll
            for (int st = 0; st < 4; ++st) acc = MFMA32(kf[st], Qf[st], acc);
          }
          bf16x8 vf[4];
          vf[0] = *(const LAS bf16x8*)(lds + vslot0 + (2 * cbi * 64) * 16); vf[1] = *(const LAS bf16x8*)(lds + vslot0 + (2 * cbi * 64 + 32) * 16);
          vf[2] = *(const LAS bf16x8*)(lds + vslot1 + (2 * cbi * 64) * 16); vf[3] = *(const LAS bf16x8*)(lds + vslot1 + (2 * cbi * 64 + 32) * 16);
          float tm = fmaxf(fmaxf(fmaxf(acc[0], acc[1]), fmaxf(acc[2], acc[3])), fmaxf(fmaxf(acc[4], acc[5]), fmaxf(acc[6], acc[7])));
          tm = fmaxf(tm, fmaxf(fmaxf(fmaxf(acc[8], acc[9]), fmaxf(acc[10], acc[11])), fmaxf(fmaxf(acc[12], acc[13]), fmaxf(acc[14], acc[15]))));
          tm = half_swap_max(tm);
          const float mn = fmaxf(mx, tm), alpha = __builtin_amdgcn_exp2f(mx - mn);
          mx = mn;
          bf16x8 Pf[2]; float ts = 0.f;
#pragma unroll
          for (int st = 0; st < 2; ++st) {
            float pv[8];
#pragma unroll
            for (int j = 0; j < 8; ++j) { pv[j] = __builtin_amdgcn_exp2f(acc[8 * st + j] - mn); ts += pv[j]; }
            u32x4 pk; pk.x = cvt_pk_bf16(pv[0], pv[1]); pk.y = cvt_pk_bf16(pv[2], pv[3]); pk.z = cvt_pk_bf16(pv[4], pv[5]); pk.w = cvt_pk_bf16(pv[6], pv[7]);
            Pf[st] = __builtin_bit_cast(bf16x8, pk);
          }
          lsum = lsum * alpha + ts;
#pragma unroll
          for (int i = 0; i < 16; ++i) { o0[i] *= alpha; o1[i] *= alpha; }
          o0 = MFMA32(vf[0], Pf[0], o0);
          o1 = MFMA32(vf[1], Pf[0], o1);
          o0 = MFMA32(vf[2], Pf[1], o0);
          o1 = MFMA32(vf[3], Pf[1], o1);
        }
        if (nO >= 1) { *(LAS u32x4*)(lds + ((hi + 1) & 7) * 16384 + tid * 16) = pkO0; *(LAS u32x4*)(lds + ((hi + 1) & 7) * 16384 + 8192 + tid * 16) = pvO0; }
        if (nO >= 2) { *(LAS u32x4*)(lds + ((hi + 2) & 7) * 16384 + tid * 16) = pkO1; *(LAS u32x4*)(lds + ((hi + 2) & 7) * 16384 + 8192 + tid * 16) = pvO1; }
        hi = req; nO = nN; pkO0 = pkN0; pvO0 = pvN0; pkO1 = pkN1; pvO1 = pvN1;
      }
      lsum = half_swap_sum(lsum);
      const float inv = __builtin_amdgcn_rcpf(lsum);
      {
        LAS unsigned char* ot = lds + 139264 + w * 2176;
        bf16_t* obase = a_na + (tokQ - ql) * NAW + head * NADH;
#pragma unroll
        for (int k = 0; k < 2; ++k) {
          if ((ql >> 4) == k) {
#pragma unroll
            for (int g = 0; g < 4; ++g) {
              u32x2 pk; pk.x = cvt_pk_bf16(o0[4 * g] * inv, o0[4 * g + 1] * inv); pk.y = cvt_pk_bf16(o0[4 * g + 2] * inv, o0[4 * g + 3] * inv);
              *(LAS u32x2*)(ot + (ql & 15) * 136 + (8 * g + 4 * hh) * 2) = pk;
              pk.x = cvt_pk_bf16(o1[4 * g] * inv, o1[4 * g + 1] * inv); pk.y = cvt_pk_bf16(o1[4 * g + 2] * inv, o1[4 * g + 3] * inv);
              *(LAS u32x2*)(ot + (ql & 15) * 136 + (32 + 8 * g + 4 * hh) * 2) = pk;
            }
          }
#pragma unroll
          for (int j = 0; j < 2; ++j) {
            const int q = lane + 64 * j, tl = q >> 3, pc = q & 7;
            const u32x2 lo2 = *(const LAS u32x2*)(ot + tl * 136 + pc * 16), hi2 = *(const LAS u32x2*)(ot + tl * 136 + pc * 16 + 8);
            st_wt16(obase + (size_t)(16 * k + tl) * NAW + pc * 8, (u32x4){lo2.x, lo2.y, hi2.x, hi2.y});
          }
        }
      }
    }
  }
#undef NA_NEED
#undef NA_RS
#undef NA_QLD
  GRID_BAR();
  { PHASE_IDS
    const int w = __builtin_amdgcn_readfirstlane(wid);
    const int seq = bid >> 2, sg = bid & 3, b = seq >> 3, dir = (seq >> 2) & 1, head = seq & 3;
    if (sg > 0) {
      const bf16_t* Gp = dir ? GBW : GF; bf16_t* ob = dir ? obb : obf;
      const size_t t0 = (size_t)b * SEQ;
      const int hh = lane >> 5, r = lane & 31;
      constexpr float LOG2E = 1.4426950408889634f;
      const int kbS = w >> 1, vbS = 2 * (w & 1), ibO = w >> 2, vbO = w & 3;
      {
        f32x16 s0, s1;
#pragma unroll
        for (int i = 0; i < 16; ++i) { s0[i] = 0.f; s1[i] = 0.f; }
        f32x16 l0[3], l1[3], ld[3];
#pragma unroll
        for (int q = 0; q < 3; ++q) {
          const int qq = q < sg ? q : 0;
          const float* sl = Sloc + (size_t)(seq * 4 + qq) * 128 * 128; const float* dt = Dtot + (size_t)(seq * 4 + qq) * 128;
#pragma unroll
          for (int rg = 0; rg < 16; ++rg) { const int k = kbS * 32 + (rg & 3) + 8 * (rg >> 2) + 4 * hh;
            ld[q][rg] = dt[k]; l0[q][rg] = sl[k * 128 + vbS * 32 + r]; l1[q][rg] = sl[k * 128 + vbS * 32 + 32 + r]; }
        }
#pragma unroll
        for (int q = 0; q < 3; ++q) {
          if (q < sg) {
#pragma unroll
            for (int rg = 0; rg < 16; ++rg) { const float dk = __builtin_amdgcn_exp2f(ld[q][rg]); s0[rg] = s0[rg] * dk + l0[q][rg]; s1[rg] = s1[rg] * dk + l1[q][rg]; }
          }
        }
#pragma unroll
        for (int g = 0; g < 4; ++g) {
          u32x2 pk; pk.x = cvt_pk_bf16(s0[4 * g], s0[4 * g + 1]); pk.y = cvt_pk_bf16(s0[4 * g + 2], s0[4 * g + 3]);
          *(LAS u32x2*)(lds + SC_ST + (vbS * 32 + r) * 272 + (kbS * 32 + 8 * g + 4 * hh) * 2) = pk;
          pk.x = cvt_pk_bf16(s1[4 * g], s1[4 * g + 1]); pk.y = cvt_pk_bf16(s1[4 * g + 2], s1[4 * g + 3]);
          *(LAS u32x2*)(lds + SC_ST + (vbS * 32 + 32 + r) * 272 + (kbS * 32 + 8 * g + 4 * hh) * 2) = pk;
        }
      }
      const int coff = head * HGD + 2 * lane;
      float bp0 = 0.f, bp1 = 0.f;
      unsigned gq[8], gg[8], gqn[8], ggn[8];
#define P2S_LOAD(c_, Q_, G_) do { _Pragma("unroll") for (int e = 0; e < 8; ++e) { const size_t tk = t0 + SC_TOK(32 * sg + (c_), 8 * w + e); Q_[e] = *(const unsigned*)(HQ + tk * HGW + coff); G_[e] = *(const unsigned*)(Gp + tk * HGW + coff); } } while (0)
      P2S_LOAD(0, gq, gg);
      for (int c = 0; c < 32; ++c) {
        if (!__any(bp0 > -160.f || bp1 > -160.f)) break;
        const int cg_ = 32 * sg + c;
        P2S_LOAD(c + 1 < 32 ? c + 1 : c, gqn, ggn);
        float c0[8], c1[8];
        { float a0 = 0.f, a1 = 0.f;
#pragma unroll
          for (int e = 0; e < 8; ++e) { a0 += h2f((unsigned short)(gg[e] & 0xffffu)) * LOG2E; a1 += h2f((unsigned short)(gg[e] >> 16)) * LOG2E; c0[e] = a0; c1[e] = a1; }
          *(LAS f32x2*)(lds + SC_TOT + (w * 128 + 2 * lane) * 4) = (f32x2){a0, a1}; }
        __syncthreads();
        float off0 = bp0, off1 = bp1, bl0 = 0.f, bl1 = 0.f;
#pragma unroll
        for (int w2 = 0; w2 < 8; ++w2) { const f32x2 tv = *(const LAS f32x2*)(lds + SC_TOT + (w2 * 128 + 2 * lane) * 4);
          bl0 += tv.x; bl1 += tv.y; if (w2 < w) { off0 += tv.x; off1 += tv.y; } }
        bp0 += bl0; bp1 += bl1;
#pragma unroll
        for (int e = 0; e < 8; ++e) {
          const float q0 = __uint_as_float(gq[e] << 16), q1 = __uint_as_float(gq[e] & 0xffff0000u);
          *(LAS unsigned*)(lds + SC_QP + (8 * w + e) * 272 + lane * 4) = cvt_pk_bf16(q0 * __builtin_amdgcn_exp2f(off0 + c0[e]), q1 * __builtin_amdgcn_exp2f(off1 + c1[e]));
        }
        __syncthreads();
        f32x16 oacc;
#pragma unroll
        for (int i = 0; i < 16; ++i) oacc[i] = 0.f;
        { bf16x8 fa[8], fb[8];
#pragma unroll
          for (int st = 0; st < 8; ++st) { fa[st] = ldfrag(lds + SC_QP, 272, ibO * 32 + r, 8 * hh + 16 * st); fb[st] = ldfrag(lds + SC_ST, 272, vbO * 32 + r, 8 * hh + 16 * st); }
          __builtin_amdgcn_sched_barrier(0);
#pragma unroll
          for (int st = 0; st < 8; ++st) oacc = MFMA32(fa[st], fb[st], oacc); }
        {
          unsigned short ov[16];
#pragma unroll
          for (int rg = 0; rg < 16; ++rg) { const int i = ibO * 32 + (rg & 3) + 8 * (rg >> 2) + 4 * hh; ov[rg] = ob[(t0 + SC_TOK(cg_, i)) * HGW + head * HGD + vbO * 32 + r]; }
          asm volatile("" : "+v"(ov[0]), "+v"(ov[1]), "+v"(ov[2]), "+v"(ov[3]), "+v"(ov[4]), "+v"(ov[5]), "+v"(ov[6]), "+v"(ov[7]));
          asm volatile("" : "+v"(ov[8]), "+v"(ov[9]), "+v"(ov[10]), "+v"(ov[11]), "+v"(ov[12]), "+v"(ov[13]), "+v"(ov[14]), "+v"(ov[15]));
#pragma unroll
          for (int rg = 0; rg < 16; ++rg) { const int i = ibO * 32 + (rg & 3) + 8 * (rg >> 2) + 4 * hh;
            ob[(t0 + SC_TOK(cg_, i)) * HGW + head * HGD + vbO * 32 + r] = __builtin_bit_cast(unsigned short, (__bf16)(bf2f(ov[rg]) + oacc[rg])); }
        }
        __syncthreads();
#pragma unroll
        for (int e = 0; e < 8; ++e) { gq[e] = gqn[e]; gg[e] = ggn[e]; }
      }
#undef P2S_LOAD
    }
  }
#undef SC_TOK
#undef SC_LOAD
  GRID_BAR();
  { PHASE_IDS
    f32x4 ng0 = *(const f32x4*)(hg_ng + lane * 8), ng1 = *(const f32x4*)(hg_ng + lane * 8 + 4);
    u32x4 fan[2], fbn[2], ggn[2];
#define P2B_LOAD(t_) do { _Pragma("unroll") for (int q = 0; q < 2; ++q) { const size_t o0 = (size_t)((t_) + q) * HGW + lane * 8; \
      fan[q] = __builtin_nontemporal_load((const u32x4*)(obf + o0)); fbn[q] = __builtin_nontemporal_load((const u32x4*)(obb + o0)); ggn[q] = __builtin_nontemporal_load((const u32x4*)(HG + o0)); } } while (0)
    P2B_LOAD(2 * gw);
#pragma unroll 1
    for (int t = 2 * gw; t < NTOK; t += 2 * NGW) {
      u32x4 fa[2], fb[2], gg2[2];
#pragma unroll
      for (int q = 0; q < 2; ++q) { fa[q] = fan[q]; fb[q] = fbn[q]; gg2[q] = ggn[q]; }
      if (t + 2 * NGW < NTOK) P2B_LOAD(t + 2 * NGW);
#pragma unroll
      for (int q = 0; q < 2; ++q) {
        float a[8]; float ss = 0.f;
#pragma unroll
        for (int e = 0; e < 4; ++e) {
          a[2 * e] = __uint_as_float(fa[q][e] << 16) + __uint_as_float(fb[q][e] << 16);
          a[2 * e + 1] = __uint_as_float(fa[q][e] & 0xffff0000u) + __uint_as_float(fb[q][e] & 0xffff0000u);
          ss += a[2 * e] * a[2 * e] + a[2 * e + 1] * a[2 * e + 1];
        }
        ss = row_sum16(ss);
        const float rs = rsqrtf(ss * (1.f / HGD) + RMS_EPS);
        const float ngv[8] = {ng0.x, ng0.y, ng0.z, ng0.w, ng1.x, ng1.y, ng1.z, ng1.w};
        float o[8];
#pragma unroll
        for (int e = 0; e < 4; ++e) {
          o[2 * e] = a[2 * e] * rs * ngv[2 * e] * __uint_as_float(gg2[q][e] << 16);
          o[2 * e + 1] = a[2 * e + 1] * rs * ngv[2 * e + 1] * __uint_as_float(gg2[q][e] & 0xffff0000u);
        }
        u32x4 w; w.x = cvt_pk_bf16(o[0], o[1]); w.y = cvt_pk_bf16(o[2], o[3]); w.z = cvt_pk_bf16(o[4], o[5]); w.w = cvt_pk_bf16(o[6], o[7]);
        st_wt16(c_hg + (size_t)(t + q) * HGW + lane * 8, w);
      }
    }
#undef P2B_LOAD
  }
  GRID_BAR();
  {
    pg8::Gemm g{c_hg, WT_pb, HGW, 0, a_na, WT_pa, HGW / 64}; pg8::StaticOrder S; S.init(NTOK, D, G, bid);
    pg8::EpiGate<0> E{GA, GBT, merged};
    pg8::gemm_phase<pg8::EpiGate<0>, pg8::StaticOrder, true>(lds, g, S, E, (HGW + NAW) / 64);
  }
  GRID_BAR();
  {
    pg8::Gemm g{merged, WT_out, D, 0}; pg8::StaticOrder S; S.init(NTOK, D, G, bid, true);
    pg8::EpiBf16 E{T1, D};
    pg8::gemm_phase(lds, g, S, E);
  }
  GRID_BAR();
  { PHASE_IDS
    for (int i = bid * NT + tid; i < MAXROWS; i += G * NT) srt[i] = 0;
    LAS f32x4* WE = (LAS f32x4*)lds; LAS f32x4* WG = (LAS f32x4*)(lds + 131072); LAS u32x2* PRM = (LAS u32x2*)(lds + 147456);
    LAS int* lcnt = (LAS int*)(lds + 155648); LAS float* rbias = (LAS float*)(lds + 155648 + 128);
    {
      f32x4 tw[16], tg2[2];
#pragma unroll
      for (int k = 0; k < 16; ++k) { const int idx = tid + k * NT; tw[k] = *(const f32x4*)(w_re + (size_t)(idx >> 3) * NE + 4 * (idx & 7)); }
#pragma unroll
      for (int k = 0; k < 2; ++k) tg2[k] = *(const f32x4*)(w_rg + (size_t)(tid + k * NT) * NG);
#pragma unroll
      for (int k = 0; k < 16; ++k) { const int idx = tid + k * NT; const int row = idx >> 3, q = idx & 7, jj = row >> 6, l = (row >> 2) & 15, e = row & 3; WE[((jj * 4 + e) * 8 + q) * 16 + l] = tw[k]; }
#pragma unroll
      for (int k = 0; k < 2; ++k) { const int row = tid + k * NT; const int jj = row >> 6, l = (row >> 2) & 15, e = row & 3; WG[(jj * 4 + e) * 16 + l] = tg2[k]; }
    }
    {
      static_assert(NT == 512, "PRM fill");
      f32x4 pv2[2];
#pragma unroll
      for (int k = 0; k < 2; ++k) { const int idx = tid + k * NT, which = idx >> 8, c4 = idx & 255;
        const float* src = which == 0 ? emb_g : (which == 1 ? emb_b : (which == 2 ? ln1_g : ln1_b)); pv2[k] = *(const f32x4*)(src + 4 * c4); }
#pragma unroll
      for (int k = 0; k < 2; ++k) { const int idx = tid + k * NT, which = idx >> 8, c4 = idx & 255;
        f32x4 pv = pv2[k]; if (which == 1) pv = pv * ALPHA;
        u32x2 pk; pk.x = pk2h(pv.x, pv.y); pk.y = pk2h(pv.z, pv.w); PRM[(which * 16 + (c4 >> 4)) * 16 + (c4 & 15)] = pk; }
    }
    if (tid < NE) { lcnt[tid] = 0; rbias[4 + tid] = b_re[tid]; } if (tid < NG) rbias[tid] = b_rg[tid];
    __syncthreads();
    const int l16 = lane & 15, tg = lane >> 4;
    constexpr float LOG2E = 1.4426950408889634f;
#define P3D_H4(w_) (f32x4){h2f((unsigned short)((w_).x & 0xffffu)), h2f((unsigned short)((w_).x >> 16)), h2f((unsigned short)((w_).y & 0xffffu)), h2f((unsigned short)((w_).y >> 16))}
    u32x2 xn[16], mn[16];
#define P3D_LOAD(t_) do { const u32x2* xr_ = (const u32x2*)(hb + (size_t)(t_) * D) + l16; const u32x2* mr_ = (const u32x2*)(T1 + (size_t)(t_) * D) + l16; \
      _Pragma("unroll") for (int jj = 0; jj < 16; ++jj) { xn[jj] = __builtin_nontemporal_load(xr_ + 16 * jj); mn[jj] = __builtin_nontemporal_load(mr_ + 16 * jj); } } while (0)
    P3D_LOAD(bid * 256 + wid * 32 + tg);
#pragma unroll 1
    for (int it = 0; it < 8; ++it) {
      const int t = bid * 256 + wid * 32 + 4 * it + tg;
      f32x4 v[16]; float s = 0.f;
      {
        u32x2 hv[16], mv[16];
#pragma unroll
        for (int jj = 0; jj < 16; ++jj) { hv[jj] = xn[jj]; mv[jj] = mn[jj]; }
        if (it < 7) P3D_LOAD(t + 4);
#pragma unroll
        for (int jj = 0; jj < 16; ++jj) {
          const f32x4 hx4 = (f32x4){__uint_as_float(hv[jj].x << 16), __uint_as_float(hv[jj].x & 0xffff0000u), __uint_as_float(hv[jj].y << 16), __uint_as_float(hv[jj].y & 0xffff0000u)};
          const f32x4 mx4 = (f32x4){__uint_as_float(mv[jj].x << 16), __uint_as_float(mv[jj].x & 0xffff0000u), __uint_as_float(mv[jj].y << 16), __uint_as_float(mv[jj].y & 0xffff0000u)};
          v[jj] = hx4 * ALPHA + mx4;
          s += (v[jj].x + v[jj].y) + (v[jj].z + v[jj].w);
        }
      }
      const float mean = row_sum16(s) * (1.f / D); float s2 = 0.f;
#pragma unroll
      for (int jj = 0; jj < 16; ++jj) { v[jj] = v[jj] - mean; s2 += (v[jj].x * v[jj].x + v[jj].y * v[jj].y) + (v[jj].z * v[jj].z + v[jj].w * v[jj].w); }
      const float rstd = rsqrtf(row_sum16(s2) * (1.f / D) + LN_EPS);
      float gl[NG];
#pragma unroll
      for (int i = 0; i < NG; ++i) gl[i] = 0.f;
      u32x2* o8 = (u32x2*)(h1b + (size_t)t * D) + l16;
#pragma unroll
      for (int jj = 0; jj < 16; ++jj) {
        const f32x4 lg = P3D_H4(PRM[(2 * 16 + jj) * 16 + l16]), lb_ = P3D_H4(PRM[(3 * 16 + jj) * 16 + l16]);
        const f32x4 o = v[jj] * rstd * lg + lb_;
        v[jj] = o;
        u32x2 w; w.x = cvt_pk_bf16(o.x, o.y); w.y = cvt_pk_bf16(o.z, o.w); st_wt8(o8 + 16 * jj, w);
#pragma unroll
        for (int e = 0; e < 4; ++e) {
          const f32x4 wg = WG[(jj * 4 + e) * 16 + l16];
          gl[0] = fmaf(o[e], wg.x, gl[0]); gl[1] = fmaf(o[e], wg.y, gl[1]); gl[2] = fmaf(o[e], wg.z, gl[2]); gl[3] = fmaf(o[e], wg.w, gl[3]);
        }
      }
#pragma unroll
      for (int i = 0; i < NG; ++i) gl[i] = row_sum16(gl[i]) + rbias[i];
      int gs = 0; float gm = gl[0];
#pragma unroll
      for (int i = 1; i < NG; ++i) if (gl[i] > gm) { gm = gl[i]; gs = i; }
      float gden = 0.f;
#pragma unroll
      for (int i = 0; i < NG; ++i) gden += __builtin_amdgcn_exp2f((gl[i] - gm) * LOG2E);
      const float gwt = 1.f / gden;
      float ev[EPG];
#pragma unroll
      for (int i = 0; i < EPG; ++i) ev[i] = 0.f;
      const LAS f32x4* wes = WE + (2 * gs) * 16 + l16;
#pragma unroll
      for (int jj = 0; jj < 16; ++jj) {
#pragma unroll
        for (int e = 0; e < 4; ++e) {
          const f32x4 wa = wes[(jj * 4 + e) * 8 * 16], wb = wes[(jj * 4 + e) * 8 * 16 + 16]; const float ov = v[jj][e];
          ev[0] = fmaf(ov, wa.x, ev[0]); ev[1] = fmaf(ov, wa.y, ev[1]); ev[2] = fmaf(ov, wa.z, ev[2]); ev[3] = fmaf(ov, wa.w, ev[3]);
          ev[4] = fmaf(ov, wb.x, ev[4]); ev[5] = fmaf(ov, wb.y, ev[5]); ev[6] = fmaf(ov, wb.z, ev[6]); ev[7] = fmaf(ov, wb.w, ev[7]);
        }
      }
#pragma unroll
      for (int i = 0; i < EPG; ++i) ev[i] = row_sum16(ev[i]) + rbias[4 + gs * EPG + i];
      int i0 = 0; float m0 = ev[0];
#pragma unroll
      for (int i = 1; i < EPG; ++i) if (ev[i] > m0) { m0 = ev[i]; i0 = i; }
      int i1 = -1; float m1v = -3.0e38f;
#pragma unroll
      for (int i = 0; i < EPG; ++i) if (i != i0 && ev[i] > m1v) { m1v = ev[i]; i1 = i; }
      const float p1 = __builtin_amdgcn_exp2f((m1v - m0) * LOG2E);
      if (l16 == 0) {
        const int e0 = gs * EPG + i0, e1 = gs * EPG + i1;
        tok_w[2 * t] = gwt / (1.f + p1); tok_w[2 * t + 1] = gwt * p1 / (1.f + p1);
        tok_e[2 * t] = e0; tok_e[2 * t + 1] = e1;
        tok_p[2 * t] = __hip_atomic_fetch_add(lcnt + e0, 1, __ATOMIC_RELAXED, __HIP_MEMORY_SCOPE_WORKGROUP);
        tok_p[2 * t + 1] = __hip_atomic_fetch_add(lcnt + e1, 1, __ATOMIC_RELAXED, __HIP_MEMORY_SCOPE_WORKGROUP);
      }
    }
#undef P3D_H4
#undef P3D_LOAD
    __syncthreads();
    if (tid < NE) blk_base[bid * NE + tid] = atomicAdd(&cnt[tid], lcnt[tid]);
    __syncthreads();
  }
  GRID_BAR();
  { PHASE_IDS
    LAS int* loff = (LAS int*)lds;
    if (tid < 64) {
      const int e = lane; const int c_e = (e < NE) ? cnt[e] : 0; const int nt_e = (c_e + 255) >> 8;
      int incl = nt_e;
#pragma unroll
      for (int d = 1; d < 32; d <<= 1) { const int v = __shfl_up(incl, d); if (lane >= d) incl += v; }
      const int start = (incl - nt_e) << 8;
      if (e < NE) loff[e] = start;
      if (e == NE - 1) loff[NE] = incl << 8;
      if (bid == 0) {
        if (e < NE) { for (int q = 0; q < nt_e; ++q) tile_e[(start >> 8) + q] = e; offs[e] = start; }
        if (e == NE - 1) { *nmt_p = incl; offs[NE] = incl << 8; }
      }
    }
    __syncthreads();
    for (int it = bid * NT + tid; it < NTOK * 2; it += G * NT) {
      const int t = it >> 1; const int ee = tok_e[it];
      const int row = loff[ee] + blk_base[(t >> 8) * NE + ee] + tok_p[it];
      srt[row] = t; tok_p[it] = row;
    }
    __syncthreads();
  }
  GRID_BAR();
  {
    const int nmt = *nmt_p;
    {
      LAS int* le = (LAS int*)(lds + pg8::GEMM_LE_OFF);
      if (threadIdx.x < 16) { const int per = (nmt + 7) >> 3, k_ = (bid >> 3) >> 2; int cnt = nmt - (bid & 7) * per; cnt = cnt < 0 ? 0 : (cnt > per ? per : cnt);
        const int lt = (int)threadIdx.x * 8 + k_, pm = (bid & 7) * per + lt; const int te_ = tile_e[pm]; le[threadIdx.x] = lt < cnt ? te_ : 0; }
      if (threadIdx.x == 16) le[16] = nmt;
      __syncthreads();
    }
    pg8::Gemm g{h1b, WT_gu, D, (size_t)1024 * D * 2, nullptr, nullptr, 0, srt}; pg8::GroupedOrder S{(const LAS int*)(lds + pg8::GEMM_LE_OFF), nmt, G, bid, false};
    pg8::EpiSwiGLU E{hid};
    pg8::gemm_phase<pg8::EpiSwiGLU, pg8::GroupedOrder, false, true>(lds, g, S, E);
  }
  GRID_BAR();
  {
    pg8::Gemm g{hid, WT_d, DFF, (size_t)1024 * DFF * 2}; pg8::GroupedOrder S{(const LAS int*)(lds + pg8::GEMM_LE_OFF), ((const LAS int*)(lds + pg8::GEMM_LE_OFF))[16], G, bid, true};
    pg8::EpiBf16 E{ybuf, D};
    pg8::gemm_phase(lds, g, S, E);
  }
  GRID_BAR();
  { PHASE_IDS
    f32x4 gq4[4], bq4[4];
#pragma unroll
    for (int j = 0; j < 4; ++j) { gq4[j] = ((const f32x4*)ln2_g)[lane + 64 * j]; bq4[j] = ((const f32x4*)ln2_b)[lane + 64 * j]; }
    u32x2 hbv[4], yav[4], ycv[4];
    int rA = 0, rB = 0; float wA = 0.f, wB = 0.f;
#define P5_IDX(t_) do { rA = tok_p[2 * (t_)]; rB = tok_p[2 * (t_) + 1]; wA = tok_w[2 * (t_)]; wB = tok_w[2 * (t_) + 1]; } while (0)
#define P5_LOAD(t_) do { \
      const u32x2* hb_ = (const u32x2*)(h1b + (size_t)(t_) * D) + lane; const u32x2* ya_ = (const u32x2*)(ybuf + (size_t)rA * D) + lane; const u32x2* yc_ = (const u32x2*)(ybuf + (size_t)rB * D) + lane; \
      _Pragma("unroll") for (int j = 0; j < 4; ++j) { hbv[j] = __builtin_nontemporal_load(hb_ + 64 * j); yav[j] = __builtin_nontemporal_load(ya_ + 64 * j); ycv[j] = __builtin_nontemporal_load(yc_ + 64 * j); } } while (0)
    float w0n = 0.f, w1n = 0.f;
    if (gw < NTOK) { P5_IDX(gw); P5_LOAD(gw); w0n = wA; w1n = wB; if (gw + NGW < NTOK) P5_IDX(gw + NGW); }
    for (int t = gw; t < NTOK; t += NGW) {
      f32x4 v[4]; float s = 0.f; const float w0 = w0n, w1 = w1n;
#pragma unroll
      for (int j = 0; j < 4; ++j) {
        const u32x2 hb2 = hbv[j], a = yav[j], c = ycv[j];
        const f32x4 hv = (f32x4){__uint_as_float(hb2.x << 16), __uint_as_float(hb2.x & 0xffff0000u), __uint_as_float(hb2.y << 16), __uint_as_float(hb2.y & 0xffff0000u)};
        const f32x4 ya = (f32x4){__uint_as_float(a.x << 16), __uint_as_float(a.x & 0xffff0000u), __uint_as_float(a.y << 16), __uint_as_float(a.y & 0xffff0000u)};
        const f32x4 yc = (f32x4){__uint_as_float(c.x << 16), __uint_as_float(c.x & 0xffff0000u), __uint_as_float(c.y << 16), __uint_as_float(c.y & 0xffff0000u)};
        v[j] = hv * ALPHA + (ya * w0 + yc * w1);
        s += (v[j].x + v[j].y) + (v[j].z + v[j].w);
      }
      if (t + NGW < NTOK) { P5_LOAD(t + NGW); w0n = wA; w1n = wB; if (t + 2 * NGW < NTOK) P5_IDX(t + 2 * NGW); }
      const float mean = wave_sum(s) * (1.f / D); float s2 = 0.f;
#pragma unroll
      for (int j = 0; j < 4; ++j) { v[j] = v[j] - mean; s2 += (v[j].x * v[j].x + v[j].y * v[j].y) + (v[j].z * v[j].z + v[j].w * v[j].w); }
      const float rstd = rsqrtf(wave_sum(s2) * (1.f / D) + LN_EPS);
      f32x4* hr = (f32x4*)(h1 + (size_t)t * D) + lane;
#pragma unroll
      for (int j = 0; j < 4; ++j) hr[64 * j] = v[j] * rstd * gq4[j] + bq4[j];
    }
#undef P5_IDX
#undef P5_LOAD
  }
}

extern "C" void kernel_launch(void* const* d_in, const int* in_sizes, int n_in, void* d_out, int out_size,
                              void* d_ws, size_t ws_size, hipStream_t stream) {
  constexpr size_t kDynLds = LDS_BYTES;
  static int grid_blocks = 0;
  if (!grid_blocks) {
    int dev = 0, cus = 0, per_cu = 0;
    (void)hipGetDevice(&dev);
    (void)hipDeviceGetAttribute(&cus, hipDeviceAttributeMultiprocessorCount, dev);
    (void)hipFuncSetAttribute((const void*)fwd_megakernel, hipFuncAttributeMaxDynamicSharedMemorySize, (int)kDynLds);
    (void)hipOccupancyMaxActiveBlocksPerMultiprocessor(&per_cu, fwd_megakernel, NT, kDynLds);
    if (per_cu < 1) fprintf(stderr, "occupancy query says %d blocks per CU\n", per_cu);
    grid_blocks = 256;
    if (cus < 256) fprintf(stderr, "device has %d CUs; this kernel needs 256 resident workgroups\n", cus);
    if (ws_size < WS_END) fprintf(stderr, "workspace too small: %zu < %zu\n", ws_size, (size_t)WS_END);
  }
  Params p{};
  for (int i = 0; i < 21; ++i) p.in[i] = (const float*)d_in[i];
  p.out = (float*)d_out; p.ws = (unsigned char*)d_ws;
  void* args[] = {&p};
  hipError_t e = hipLaunchCooperativeKernel((void*)fwd_megakernel, dim3(grid_blocks), dim3(NT), args, kDynLds, stream);
  if (e != hipSuccess) fprintf(stderr, "cooperative launch failed: %s (grid %d)\n", hipGetErrorString(e), grid_blocks);
}
```
